# Optimizing an MI355X kernel written in HIP

```python
import math
import jax, jax.numpy as jnp
from jax import lax
import numpy as np

D_MODEL = 1024
BATCH = 8
SEQ = 4096
DEPTH = 4

N_MIXERS = 2
ATTN_HEADS = 8
ATTN_HEAD_DIM = D_MODEL // (2 * ATTN_HEADS)
ATTN_V_DIM = 2 * ATTN_HEAD_DIM
ATTN_WIDTH = ATTN_HEADS * ATTN_V_DIM
ATTN_IN = 4 * ATTN_WIDTH
Q_BLOCK = 128
LAMBDA_STD = 0.1
SGU_EXPAND = 2
SGU_WIDTH = SGU_EXPAND * D_MODEL
SGU_GROUPS = 8
SGU_GROUP_DIM = SGU_WIDTH // SGU_GROUPS
SGU_IN = 3 * SGU_WIDTH
CHUNK = 128
PLE_DIM = 256

N_ATTN_LAYERS = (DEPTH + 1) // 2
N_SGU_LAYERS = DEPTH // 2
NORM_EPS = 1e-6
SUBLN_EPS = 1e-5
LN_EPS = 1e-5

kernel_name = "hybrid_diffattn_chunked_sgu_ple"


def rms_norm(x, g, eps=NORM_EPS):
    xf = x.astype(jnp.float32)
    y = xf * lax.rsqrt(jnp.mean(xf * xf, axis=-1, keepdims=True) + eps)
    return (y * g.astype(jnp.float32)).astype(x.dtype)


def layer_norm(x, g, b, eps=LN_EPS):
    xf = x.astype(jnp.float32)
    mu = jnp.mean(xf, axis=-1, keepdims=True)
    xc = xf - mu
    var = jnp.mean(xc * xc, axis=-1, keepdims=True)
    y = xc * lax.rsqrt(var + eps) * g.astype(jnp.float32) + b.astype(jnp.float32)
    return y.astype(x.dtype)


def alibi_slopes(n_heads):
    return jnp.asarray(2.0 ** (-8.0 * np.arange(1, n_heads + 1) / n_heads), dtype=jnp.float32)


def diff_attention_mixer(h, w_in, lam_q1, lam_k1, lam_q2, lam_k2, subln_g, w_out, lambda_init):
    B, S, _ = h.shape
    H, dh, dv = ATTN_HEADS, ATTN_HEAD_DIM, ATTN_V_DIM
    z = h @ w_in
    q, k, v, gate = jnp.split(z, 4, axis=-1)
    q = q.reshape(B, S, H, 2, dh)
    k = k.reshape(B, S, H, 2, dh)
    q1, q2 = q[..., 0, :], q[..., 1, :]
    k1, k2 = k[..., 0, :], k[..., 1, :]
    v = v.reshape(B, S, H, dv)
    f32 = jnp.float32
    lam = (jnp.exp(jnp.sum(lam_q1.astype(f32) * lam_k1.astype(f32)))
           - jnp.exp(jnp.sum(lam_q2.astype(f32) * lam_k2.astype(f32))) + lambda_init)
    slopes = alibi_slopes(H)
    scale = dh ** -0.5
    key_pos = jnp.arange(S)
    n_blocks = S // Q_BLOCK

    def block(i):
        start = i * Q_BLOCK
        qb1 = lax.dynamic_slice_in_dim(q1, start, Q_BLOCK, axis=1)
        qb2 = lax.dynamic_slice_in_dim(q2, start, Q_BLOCK, axis=1)
        qpos = start + jnp.arange(Q_BLOCK)
        dist = (qpos[:, None] - key_pos[None, :]).astype(f32)
        causal = dist >= 0
        bias = -slopes[:, None, None] * dist[None]

        def probs(qb, kk):
            s = jnp.einsum('bqhd,bkhd->bhqk', qb, kk).astype(f32) * scale + bias
            s = jnp.where(causal, s, -jnp.inf)
            return jax.nn.softmax(s, axis=-1)

        a = probs(qb1, k1) - lam * probs(qb2, k2)
        return jnp.einsum('bhqk,bkhd->bqhd', a.astype(v.dtype), v)

    o = lax.map(block, jnp.arange(n_blocks))
    o = jnp.moveaxis(o, 0, 1).reshape(B, S, H, dv)
    o = rms_norm(o, subln_g, SUBLN_EPS) * (1.0 - lambda_init)
    o = o.reshape(B, S, ATTN_WIDTH) * jax.nn.silu(gate)
    return o @ w_out


def sgu_mixer(h, w_in, ln_g, ln_b, w_s, b_s, w_out):
    B, S, _ = h.shape
    z = h @ w_in
    uv = jax.nn.gelu(z[..., :2 * SGU_WIDTH], approximate=False)
    gate = z[..., 2 * SGU_WIDTH:]
    u, v = jnp.split(uv, 2, axis=-1)
    v = layer_norm(v, ln_g, ln_b)
    v = v.reshape(B, S // CHUNK, CHUNK, SGU_GROUPS, SGU_GROUP_DIM)
    causal = jnp.tril(jnp.ones((CHUNK, CHUNK), dtype=w_s.dtype))
    mixed = (jnp.einsum('gts,bcsgd->bctgd', w_s * causal, v)
             + b_s.T[:, :, None])
    y = u * mixed.reshape(B, S, SGU_WIDTH) * jax.nn.silu(gate)
    return y @ w_out


def setup_inputs(seed: int = 0) -> dict:
    key = jax.random.key(seed)
    ks = jax.random.split(key, 24)
    nrm = jax.random.normal
    D = D_MODEL
    na, ns = N_ATTN_LAYERS, N_SGU_LAYERS
    return {
        "x": nrm(ks[0], (BATCH, SEQ, D), jnp.float32),
        "p": nrm(ks[1], (DEPTH, BATCH, SEQ, PLE_DIM), jnp.float32),
        "attn_norm": 1.0 + 0.02 * nrm(ks[2], (na, D), jnp.float32),
        "attn_w_in": nrm(ks[3], (na, D, ATTN_IN), jnp.float32) * D ** -0.5,
        "attn_lam_q1": LAMBDA_STD * nrm(ks[4], (na, ATTN_HEAD_DIM), jnp.float32),
        "attn_lam_k1": LAMBDA_STD * nrm(ks[5], (na, ATTN_HEAD_DIM), jnp.float32),
        "attn_lam_q2": LAMBDA_STD * nrm(ks[6], (na, ATTN_HEAD_DIM), jnp.float32),
        "attn_lam_k2": LAMBDA_STD * nrm(ks[7], (na, ATTN_HEAD_DIM), jnp.float32),
        "attn_subln": 1.0 + 0.02 * nrm(ks[8], (na, ATTN_V_DIM), jnp.float32),
        "attn_w_out": nrm(ks[9], (na, ATTN_WIDTH, D), jnp.float32) * ATTN_WIDTH ** -0.5,
        "sgu_norm": 1.0 + 0.02 * nrm(ks[10], (ns, D), jnp.float32),
        "sgu_w_in": nrm(ks[11], (ns, D, SGU_IN), jnp.float32) * D ** -0.5,
        "sgu_ln_g": 1.0 + 0.02 * nrm(ks[12], (ns, SGU_WIDTH), jnp.float32),
        "sgu_ln_b": 0.02 * nrm(ks[13], (ns, SGU_WIDTH), jnp.float32),
        "sgu_w_s": nrm(ks[14], (ns, SGU_GROUPS, CHUNK, CHUNK), jnp.float32) * CHUNK ** -0.5,
        "sgu_b_s": 1.0 + 0.02 * nrm(ks[15], (ns, SGU_GROUPS, CHUNK), jnp.float32),
        "sgu_w_out": nrm(ks[16], (ns, SGU_WIDTH, D), jnp.float32) * SGU_WIDTH ** -0.5,
        "ple_proj": nrm(ks[17], (DEPTH, PLE_DIM, D), jnp.float32) * PLE_DIM ** -0.5,
        "ple_gate": nrm(ks[18], (DEPTH, D, D), jnp.float32) * D ** -0.5,
        "final_norm": 1.0 + 0.02 * nrm(ks[19], (D,), jnp.float32),
    }


def reference(x, p, attn_norm, attn_w_in, attn_lam_q1, attn_lam_k1, attn_lam_q2, attn_lam_k2,
              attn_subln, attn_w_out, sgu_norm, sgu_w_in, sgu_ln_g, sgu_ln_b, sgu_w_s, sgu_b_s,
              sgu_w_out, ple_proj, ple_gate, final_norm):
    for i in range(DEPTH):
        j = i // N_MIXERS
        if i % N_MIXERS == 0:
            lambda_init = 0.8 - 0.6 * math.exp(-0.3 * i)
            h = rms_norm(x, attn_norm[j])
            x = x + diff_attention_mixer(h, attn_w_in[j], attn_lam_q1[j], attn_lam_k1[j],
                                         attn_lam_q2[j], attn_lam_k2[j], attn_subln[j],
                                         attn_w_out[j], lambda_init)
        else:
            h = rms_norm(x, sgu_norm[j])
            x = x + sgu_mixer(h, sgu_w_in[j], sgu_ln_g[j], sgu_ln_b[j], sgu_w_s[j],
                              sgu_b_s[j], sgu_w_out[j])
        x = x + (p[i] @ ple_proj[i]) * jax.nn.sigmoid(x @ ple_gate[i])
    return rms_norm(x, final_norm)
```

```cpp
#include <hip/hip_runtime.h>
#include <hip/hip_cooperative_groups.h>
#include <cstdio>
#include <cstdint>
namespace cg = cooperative_groups;

#define DI __device__ __forceinline__
typedef unsigned short bf16_t;
typedef short bf16x8 __attribute__((ext_vector_type(8)));
typedef short s16x4 __attribute__((ext_vector_type(4)));
typedef float f32x2 __attribute__((ext_vector_type(2)));
typedef float f32x4 __attribute__((ext_vector_type(4)));
typedef float f32x16 __attribute__((ext_vector_type(16)));
typedef __bf16 bf16x2v __attribute__((ext_vector_type(2)));
typedef unsigned u32x2 __attribute__((ext_vector_type(2)));
typedef unsigned u32x4 __attribute__((ext_vector_type(4)));

constexpr int T_ = 32768, S_ = 4096;
constexpr size_t MiB = 1024 * 1024;
constexpr size_t OFF_XB = 0, OFF_BIG = 64 * MiB, OFF_WIN = 448 * MiB, OFF_WOA = 460 * MiB, OFF_WOS = 464 * MiB, OFF_WP = 472 * MiB,
                 OFF_WG = 474 * MiB, OFF_PB = 482 * MiB, OFF_SS = 498 * MiB, OFF_VST = OFF_SS + 512 * 1024, OFF_WSB = OFF_VST + 2 * MiB;
constexpr int LDS_BYTES = 128 * 1024;
#define LOG2E 1.4426950408889634f

struct Params {
    const float *x, *p, *attn_norm, *attn_w_in, *lq1, *lk1, *lq2, *lk2, *subln, *attn_w_out, *sgu_norm, *sgu_w_in, *ln_g, *ln_b, *w_s, *b_s,
        *sgu_w_out, *ple_proj, *ple_gate, *final_norm;
    float* out;
    char* ws;
    float lam_init0, lam_init2;
};

DI int otid() { int t = threadIdx.x; asm volatile("" : "+v"(t)); return t; }
DI unsigned pk2(float a, float b) { f32x2 v = {a, b}; return __builtin_bit_cast(unsigned, __builtin_convertvector(v, bf16x2v)); }
DI bf16_t f2bf(float a) { return (bf16_t)(pk2(a, 0.f) & 0xffffu); }
DI float bflo(unsigned u) { return __uint_as_float(u << 16); }
DI float bfhi(unsigned u) { return __uint_as_float(u & 0xffff0000u); }
DI float sigmoidf_(float x) { return __builtin_amdgcn_rcpf(1.f + __builtin_amdgcn_exp2f(-x * LOG2E)); }
DI float siluf_(float x) { return x * sigmoidf_(x); }
DI f32x2 gelu_pk(f32x2 v) {
    const f32x2 av = __builtin_elementwise_abs(v), d = av * 0.2316418882f + 1.0f;
    f32x2 t; t.x = __builtin_amdgcn_rcpf(d.x); t.y = __builtin_amdgcn_rcpf(d.y);
    f32x2 q = t * 0.5307027145f + (-0.7265760135f); q = q * t + 0.7107068705f; q = q * t + (-0.142248368f); q = q * t + 0.127414796f; q = q * t;
    const f32x2 s = (v * v) * (-0.72134752044f);
    f32x2 e; e.x = __builtin_amdgcn_exp2f(s.x); e.y = __builtin_amdgcn_exp2f(s.y);
    const f32x2 m = v * (q * e), r = v - m;
    f32x2 o; o.x = v.x < 0.f ? m.x : r.x; o.y = v.y < 0.f ? m.y : r.y; return o;
}
DI int fxr(int row) { return ((row & 3) << 2) | ((row >> 2) & 3); }

DI void conv_T(const float* src, int K, int N, bf16_t* dst, const float* gain, int nscale, float cs, char* ldsc) {
    float* lds = (float*)ldsc;
    const int tilesN = N / 64, ntile = (K / 64) * tilesN;
    for (int ti = blockIdx.x; ti < ntile; ti += gridDim.x) {
        const int tk = ti / tilesN, tn = ti % tilesN; const int tx = otid();
        __syncthreads();
#pragma unroll
        for (int i = 0; i < 8; ++i) {
            const int e = tx + i * 512, kk = e >> 6, nn = e & 63;
            float v = src[(size_t)(tk * 64 + kk) * N + tn * 64 + nn];
            if (gain) v *= gain[tk * 64 + kk];
            if (tn * 64 + nn < nscale) v *= cs;
            lds[kk * 65 + nn] = v;
        }
        __syncthreads();
#pragma unroll
        for (int i = 0; i < 8; ++i) {
            const int e = tx + i * 512, nn = e >> 6, kk = e & 63;
            dst[(size_t)(tn * 64 + nn) * K + tk * 64 + kk] = f2bf(lds[kk * 65 + nn]);
        }
    }
}
DI void conv_flat(const float* src, bf16_t* dst, size_t n) {
    const size_t nch = n / 8;
    const int tx = otid();
    for (size_t c = (size_t)blockIdx.x * 512 + tx; c < nch; c += (size_t)gridDim.x * 512) {
        const f32x4 a = *(const f32x4*)(src + c * 8), b = *(const f32x4*)(src + c * 8 + 4);
        u32x4 w; w.x = pk2(a[0], a[1]); w.y = pk2(a[2], a[3]); w.z = pk2(b[0], b[1]); w.w = pk2(b[2], b[3]);
        *(u32x4*)(dst + c * 8) = w;
    }
}

template <class Epi>
DI void gemm_tile(const bf16_t* A, int lda, const bf16_t* Bt, int ldb, int K, int pm, int pn, char* lds, const Epi& epi) {
    int tid_ = threadIdx.x; asm volatile("" : "+v"(tid_));
    const int tid = tid_, wid = tid >> 6, lane = tid & 63, wr = wid >> 2, wc = wid & 3, fr = lane & 15, fq = lane >> 4;
    f32x4 acc[2][2][4][2];
#pragma unroll
    for (int a = 0; a < 2; ++a)
#pragma unroll
        for (int b = 0; b < 2; ++b)
#pragma unroll
            for (int m = 0; m < 4; ++m)
#pragma unroll
                for (int n = 0; n < 2; ++n) acc[a][b][m][n] = (f32x4){0.f, 0.f, 0.f, 0.f};
    const bf16_t* Ab = A + (size_t)pm * 256 * lda;
    const bf16_t* Bb = Bt + (size_t)pn * 256 * ldb;
    char* sA = lds; char* sB = lds + 32768;
    const int nt = K / 64;
#pragma unroll 1
    for (int kt = 0; kt < nt; ++kt) {
        __syncthreads();
#pragma unroll
        for (int i = 0; i < 4; ++i) {
            const int c = tid + i * 512, r = c >> 3, ch = c & 7;
            const u32x4 va = *(const u32x4*)(Ab + (size_t)r * lda + kt * 64 + ch * 8);
            const u32x4 vb = *(const u32x4*)(Bb + (size_t)r * ldb + kt * 64 + ch * 8);
            *(u32x4*)(sA + r * 128 + ((ch ^ (r & 7)) << 4)) = va;
            *(u32x4*)(sB + r * 128 + ((ch ^ (r & 7)) << 4)) = vb;
        }
        __syncthreads();
#pragma unroll
        for (int ai = 0; ai < 2; ++ai) {
            bf16x8 At[4][2];
#pragma unroll
            for (int m = 0; m < 4; ++m)
#pragma unroll
                for (int k = 0; k < 2; ++k) { const int row = ai * 128 + wr * 64 + m * 16 + fr, ch = k * 4 + fq; At[m][k] = *(const bf16x8*)(sA + row * 128 + ((ch ^ (row & 7)) << 4)); }
#pragma unroll
            for (int bj = 0; bj < 2; ++bj) {
                bf16x8 Bf[2][2];
#pragma unroll
                for (int n = 0; n < 2; ++n)
#pragma unroll
                    for (int k = 0; k < 2; ++k) { const int row = bj * 128 + wc * 32 + n * 16 + fr, ch = k * 4 + fq; Bf[n][k] = *(const bf16x8*)(sB + row * 128 + ((ch ^ (row & 7)) << 4)); }
#pragma unroll
                for (int m = 0; m < 4; ++m)
#pragma unroll
                    for (int n = 0; n < 2; ++n)
#pragma unroll
                        for (int k = 0; k < 2; ++k) acc[ai][bj][m][n] = __builtin_amdgcn_mfma_f32_16x16x32_bf16(Bf[n][k], At[m][k], acc[ai][bj][m][n], 0, 0, 0);
            }
        }
    }
    epi(acc, pm, pn, wr, wc, fr, fq, lds);
}

#define EPI_ARGS const f32x4 (&acc)[2][2][4][2], int pm, int pn, int wr, int wc, int fr, int fq, char* lds
#define ROW_OF(ai, m) (pm * 256 + (ai) * 128 + wr * 64 + (m) * 16 + fr)
#define COL_OF(bj, n) (pn * 256 + (bj) * 128 + wc * 32 + (n) * 16 + fq * 4)
DI float rs_from_ss(const float* ss, int row) { const f32x4 s = *(const f32x4*)(ss + (size_t)row * 4); return rsqrtf((s[0] + s[1] + s[2] + s[3]) * (1.f / 1024.f) + 1e-6f); }
DI void st_bf4(bf16_t* p, f32x4 v) { u32x2 w; w.x = pk2(v[0], v[1]); w.y = pk2(v[2], v[3]); *(u32x2*)p = w; }

template <int NV, class Sink>
DI void tile_row_reduce(float (&vals)[8][NV], int wr, int wc, int fr, int fq, char* lds, Sink sink) {
#pragma unroll
    for (int i = 0; i < 8; ++i)
#pragma unroll
        for (int q = 0; q < NV; ++q) { float v = vals[i][q]; v += __shfl_xor(v, 16); v += __shfl_xor(v, 32); vals[i][q] = v; }
    float* red = (float*)lds;
    __syncthreads();
    if (fq == 0) {
#pragma unroll
        for (int i = 0; i < 8; ++i) { const int R = (i >> 2) * 128 + wr * 64 + (i & 3) * 16 + fr;
#pragma unroll
            for (int q = 0; q < NV; ++q) red[(wc * 256 + R) * NV + q] = vals[i][q]; }
    }
    __syncthreads();
    const int tx = otid();
    if (tx < 256) {
        const int R = tx; float o[NV];
#pragma unroll
        for (int q = 0; q < NV; ++q) o[q] = red[(0 * 256 + R) * NV + q] + red[(1 * 256 + R) * NV + q] + red[(2 * 256 + R) * NV + q] + red[(3 * 256 + R) * NV + q];
        sink(R, o);
    }
}

struct EpiQKVG {
    bf16_t* out; const float* ss;
    DI void operator()(EPI_ARGS) const {
#pragma unroll
        for (int ai = 0; ai < 2; ++ai)
#pragma unroll
            for (int m = 0; m < 4; ++m) { const int row = ROW_OF(ai, m); const float rs = rs_from_ss(ss, row);
#pragma unroll
                for (int bj = 0; bj < 2; ++bj)
#pragma unroll
                    for (int n = 0; n < 2; ++n) st_bf4(out + (size_t)row * 4096 + COL_OF(bj, n), acc[ai][bj][m][n] * rs); }
    }
};
struct EpiSguIn {
    bf16_t* z; const float* ss; float* vst;
    DI void operator()(EPI_ARGS) const {
        const bool do_gelu = pn < 16, do_stats = (pn >= 8) && (pn < 16);
        float vals[8][2];
#pragma unroll
        for (int ai = 0; ai < 2; ++ai)
#pragma unroll
            for (int m = 0; m < 4; ++m) { const int row = ROW_OF(ai, m); const float rs = rs_from_ss(ss, row); float s1 = 0.f, s2 = 0.f;
#pragma unroll
                for (int bj = 0; bj < 2; ++bj)
#pragma unroll
                    for (int n = 0; n < 2; ++n) { f32x4 v = acc[ai][bj][m][n] * rs;
                        if (do_gelu) { const f32x2 a = gelu_pk((f32x2){v[0], v[1]}), b = gelu_pk((f32x2){v[2], v[3]}); v = (f32x4){a.x, a.y, b.x, b.y}; }
                        s1 += (v[0] + v[1]) + (v[2] + v[3]); s2 += (v[0] * v[0] + v[1] * v[1]) + (v[2] * v[2] + v[3] * v[3]);
                        st_bf4(z + (size_t)row * 6144 + COL_OF(bj, n), v); }
                vals[ai * 4 + m][0] = s1; vals[ai * 4 + m][1] = s2; }
        if (do_stats) {
            float* vp = vst; const int pmm = pm, pnn = pn;
            tile_row_reduce<2>(vals, wr, wc, fr, fq, lds, [=](int R, const float (&o)[2]) { float* d = vp + (size_t)(pmm * 256 + R) * 16 + (pnn - 8) * 2; d[0] = o[0]; d[1] = o[1]; });
        }
    }
};
struct EpiRes {
    const float* xin; float* xr; bf16_t* xb; int ldxb;
    DI void operator()(EPI_ARGS) const {
#pragma unroll
        for (int ai = 0; ai < 2; ++ai)
#pragma unroll
            for (int m = 0; m < 4; ++m) { const int row = ROW_OF(ai, m);
#pragma unroll
                for (int bj = 0; bj < 2; ++bj)
#pragma unroll
                    for (int n = 0; n < 2; ++n) { const int col = COL_OF(bj, n); const f32x4 v = *(const f32x4*)(xin + (size_t)row * 1024 + col) + acc[ai][bj][m][n];
                        *(f32x4*)(xr + (size_t)row * 1024 + col) = v; st_bf4(xb + (size_t)row * ldxb + col, v); } }
    }
};
struct EpiE {
    bf16_t* e; int lde;
    DI void operator()(EPI_ARGS) const {
#pragma unroll
        for (int ai = 0; ai < 2; ++ai)
#pragma unroll
            for (int m = 0; m < 4; ++m) { const int row = ROW_OF(ai, m);
#pragma unroll
                for (int bj = 0; bj < 2; ++bj)
#pragma unroll
                    for (int n = 0; n < 2; ++n) st_bf4(e + (size_t)row * lde + COL_OF(bj, n), acc[ai][bj][m][n]); }
    }
};
struct EpiGate {
    float* xr; const bf16_t* e; int lde; bf16_t* xb; float* ss;
    DI void operator()(EPI_ARGS) const {
        float vals[8][1];
#pragma unroll
        for (int ai = 0; ai < 2; ++ai)
#pragma unroll
            for (int m = 0; m < 4; ++m) { const int row = ROW_OF(ai, m); float s2 = 0.f;
#pragma unroll
                for (int bj = 0; bj < 2; ++bj)
#pragma unroll
                    for (int n = 0; n < 2; ++n) { const int col = COL_OF(bj, n);
                        const f32x4 xm = *(const f32x4*)(xr + (size_t)row * 1024 + col); const u32x2 ew = *(const u32x2*)(e + (size_t)row * lde + col);
                        const f32x4 g = acc[ai][bj][m][n]; f32x4 v;
                        v[0] = xm[0] + bflo(ew.x) * sigmoidf_(g[0]); v[1] = xm[1] + bfhi(ew.x) * sigmoidf_(g[1]);
                        v[2] = xm[2] + bflo(ew.y) * sigmoidf_(g[2]); v[3] = xm[3] + bfhi(ew.y) * sigmoidf_(g[3]);
                        s2 += (v[0] * v[0] + v[1] * v[1]) + (v[2] * v[2] + v[3] * v[3]);
                        *(f32x4*)(xr + (size_t)row * 1024 + col) = v; st_bf4(xb + (size_t)row * 1024 + col, v); }
                vals[ai * 4 + m][0] = s2; }
        float* sp = ss; const int pmm = pm, pnn = pn;
        tile_row_reduce<1>(vals, wr, wc, fr, fq, lds, [=](int R, const float (&o)[1]) { sp[(size_t)(pmm * 256 + R) * 4 + pnn] = o[0]; });
    }
};

template <class Epi>
DI void gemm_phase(const bf16_t* A, int lda, const bf16_t* Bt, int ldb, int K, int nM, int nN, char* lds, const Epi& epi, int ubase, int utotal) {
    for (int u = blockIdx.x; u < utotal; u += gridDim.x) {
        const int v = u - ubase; if (v < 0 || v >= nM * nN) continue;
        gemm_tile(A, lda, Bt, ldb, K, v / nN, v % nN, lds, epi);
    }
}

DI void attn_unit(bf16_t* big, int b, int h, int qb, float lam, float slope2, const float* subln_g, float oscale, char* lds) {
    int tid_ = threadIdx.x; asm volatile("" : "+v"(tid_));
    const int tid = tid_, wid = tid >> 6, lane = tid & 63, w = wid & 3, j = wid >> 2, hf = lane >> 5, l32 = lane & 31;
    const int q0 = qb * 128;
    const size_t rowbase = (size_t)b * S_;
    const float NEG_INF = -__builtin_inff();
    bf16x8 qf[4];
    { const bf16_t* Qp = big + (rowbase + q0 + 32 * w + l32) * 4096 + h * 128 + j * 64;
#pragma unroll
      for (int ks = 0; ks < 4; ++ks) qf[ks] = *(const bf16x8*)(Qp + 16 * ks + 8 * hf); }
    f32x16 o[4];
#pragma unroll
    for (int mo = 0; mo < 4; ++mo)
#pragma unroll
        for (int r = 0; r < 16; ++r) o[mo][r] = 0.f;
    float m_run = NEG_INF, l_run = 0.f;
    const int nkt = 2 * qb + 2;
    const bf16_t* Kg = big + rowbase * 4096 + 1024 + h * 128;
    const bf16_t* Vg = big + rowbase * 4096 + 2048 + h * 128;
    u32x4 rg[4];
    auto load_tile = [&](int kt) {
        const size_t key = (size_t)kt * 64 + (tid >> 3);
        rg[0] = *(const u32x4*)(Kg + key * 4096 + (tid & 7) * 8);
        rg[1] = *(const u32x4*)(Kg + key * 4096 + 64 + (tid & 7) * 8);
#pragma unroll
        for (int i = 0; i < 2; ++i) { const int c = tid + 512 * i; const size_t k2 = (size_t)kt * 64 + (c >> 4); rg[2 + i] = *(const u32x4*)(Vg + k2 * 4096 + (c & 15) * 8); }
    };
    auto store_tile = [&](char* buf) {
        { const int row = tid >> 3, ch = tid & 7; const int o_ = row * 128 + ((ch ^ (row & 7)) << 4);
          *(u32x4*)(buf + o_) = rg[0]; *(u32x4*)(buf + 8192 + o_) = rg[1]; }
#pragma unroll
        for (int i = 0; i < 2; ++i) { const int c = tid + 512 * i, row = c >> 4, ch = c & 15; *(u32x4*)(buf + 16384 + row * 256 + ((ch ^ fxr(row)) << 4)) = rg[2 + i]; }
    };
    __syncthreads();
    load_tile(nkt - 1);
    store_tile(lds);
    __syncthreads();
    const int g_blk = (lane >> 4) & 1, g_q = (lane & 15) >> 2, g_p = lane & 3;
    int it = 0;
    for (int kt = nkt - 1; kt >= 0; --kt, ++it) {
        char* buf = lds + (it & 1) * 32768;
        char* nbuf = lds + ((it + 1) & 1) * 32768;
        if (kt > 0) load_tile(kt - 1);
        const bool skip = (64 * kt > q0 + 32 * w + 31);
        if (!skip) {
            const char* kb = buf + j * 8192; const char* vb = buf + 16384;
            f32x16 st[2];
#pragma unroll
            for (int mt = 0; mt < 2; ++mt) {
#pragma unroll
                for (int r = 0; r < 16; ++r) st[mt][r] = 0.f;
#pragma unroll
                for (int ks = 0; ks < 4; ++ks) { const int row = 32 * mt + l32, ch = 2 * ks + hf;
                    const bf16x8 kf = *(const bf16x8*)(kb + row * 128 + ((ch ^ (row & 7)) << 4));
                    st[mt] = __builtin_amdgcn_mfma_f32_32x32x16_bf16(kf, qf[ks], st[mt], 0, 0, 0); }
            }
            __builtin_amdgcn_sched_barrier(0);
            const float kbias = slope2 * (float)(64 * kt - q0 + 4 * hf);
            const bool diag = (64 * kt + 63 > q0 + 32 * w);
            const int qrel = q0 + 32 * w + l32 - 64 * kt - 4 * hf;
            float tm = NEG_INF;
#pragma unroll
            for (int mt = 0; mt < 2; ++mt)
#pragma unroll
                for (int r = 0; r < 16; ++r) { const int ko = 32 * mt + (r & 3) + 8 * (r >> 2);
                    float s = st[mt][r] + (kbias + slope2 * (float)ko);
                    if (diag && ko > qrel) s = NEG_INF;
                    st[mt][r] = s; tm = fmaxf(tm, s); }
            tm = fmaxf(tm, __shfl_xor(tm, 32));
            const float mn = fmaxf(m_run, tm);
            const float alpha = __builtin_amdgcn_exp2f(m_run - mn);
            m_run = mn;
            float ps = 0.f;
#pragma unroll
            for (int mt = 0; mt < 2; ++mt)
#pragma unroll
                for (int r = 0; r < 16; ++r) { const float p = __builtin_amdgcn_exp2f(st[mt][r] - mn); st[mt][r] = p; ps += p; }
            l_run = l_run * alpha + ps;
            if (__any(alpha != 1.f)) {
#pragma unroll
                for (int mo = 0; mo < 4; ++mo)
#pragma unroll
                    for (int r = 0; r < 16; ++r) o[mo][r] *= alpha;
            }
            __builtin_amdgcn_sched_barrier(0);
            bf16x8 pf[4];
#pragma unroll
            for (int kk = 0; kk < 4; ++kk) { const int mt = kk >> 1, s8 = (kk & 1) * 8; u32x4 pw;
                pw.x = pk2(st[mt][s8 + 0], st[mt][s8 + 1]); pw.y = pk2(st[mt][s8 + 2], st[mt][s8 + 3]);
                pw.z = pk2(st[mt][s8 + 4], st[mt][s8 + 5]); pw.w = pk2(st[mt][s8 + 6], st[mt][s8 + 7]);
                pf[kk] = __builtin_bit_cast(bf16x8, pw); }
            __builtin_amdgcn_sched_barrier(0);
#pragma unroll
            for (int mo = 0; mo < 4; ++mo)
#pragma unroll
                for (int kk = 0; kk < 4; ++kk) {
                    const int row0 = 16 * kk + 4 * hf + g_q, row1 = row0 + 8, ch = 4 * mo + 2 * g_blk + (g_p >> 1);
                    const s16x4 lo = __builtin_amdgcn_ds_read_tr16_b64_v4i16((__attribute__((address_space(3))) s16x4*)(vb + row0 * 256 + ((ch ^ fxr(row0)) << 4) + 8 * (g_p & 1)));
                    const s16x4 hi = __builtin_amdgcn_ds_read_tr16_b64_v4i16((__attribute__((address_space(3))) s16x4*)(vb + row1 * 256 + ((ch ^ fxr(row1)) << 4) + 8 * (g_p & 1)));
                    const bf16x8 vf = {lo[0], lo[1], lo[2], lo[3], hi[0], hi[1], hi[2], hi[3]};
                    o[mo] = __builtin_amdgcn_mfma_f32_32x32x16_bf16(vf, pf[kk], o[mo], 0, 0, 0);
                    if (kk == 3) __builtin_amdgcn_sched_barrier(0);
                }
        }
        if (kt > 0) store_tile(nbuf);
        __syncthreads();
    }
    const float l_tot = l_run + __shfl_xor(l_run, 32);
    float inv = 1.f / l_tot; if (j == 1) inv *= lam;
    float* ex = (float*)lds;
    if (j == 1) {
#pragma unroll
        for (int mo = 0; mo < 4; ++mo)
#pragma unroll
            for (int r = 0; r < 16; ++r) ex[(w * 64 + mo * 16 + r) * 64 + lane] = o[mo][r] * inv;
    }
    __syncthreads();
    if (j == 0) {
        float sq = 0.f;
#pragma unroll
        for (int mo = 0; mo < 4; ++mo)
#pragma unroll
            for (int r = 0; r < 16; ++r) { const float v = o[mo][r] * inv - ex[(w * 64 + mo * 16 + r) * 64 + lane]; o[mo][r] = v; sq += v * v; }
        sq += __shfl_xor(sq, 32);
        const float rn = rsqrtf(sq * (1.f / 128.f) + 1e-5f) * oscale;
        bf16_t* rowp = big + (rowbase + q0 + 32 * w + l32) * 4096 + h * 128;
#pragma unroll
        for (int mo = 0; mo < 4; ++mo)
#pragma unroll
            for (int rq = 0; rq < 4; ++rq) { const int dv = 32 * mo + 8 * rq + 4 * hf;
                const u32x2 gw = *(const u32x2*)(rowp + 3072 + dv); const f32x4 sg = *(const f32x4*)(subln_g + dv);
                f32x4 v;
                v[0] = o[mo][4 * rq + 0] * rn * sg[0] * siluf_(bflo(gw.x)); v[1] = o[mo][4 * rq + 1] * rn * sg[1] * siluf_(bfhi(gw.x));
                v[2] = o[mo][4 * rq + 2] * rn * sg[2] * siluf_(bflo(gw.y)); v[3] = o[mo][4 * rq + 3] * rn * sg[3] * siluf_(bfhi(gw.y));
                st_bf4(rowp + dv, v); }
    }
}

DI void sgu_unit(bf16_t* z, int chunk, int g, const bf16_t* wsb, const float* bs, const float* lng, const float* lnb, const float* vst, char* lds) {
    int tid_ = threadIdx.x; asm volatile("" : "+v"(tid_));
    const int tid = tid_, wid = tid >> 6, lane = tid & 63, tt = wid & 3, dh = wid >> 2, hf = lane >> 5, l32 = lane & 31;
    const int t0 = chunk * 128;
    float* stt = (float*)(lds + 65536);
    __syncthreads();
    if (tid < 128) { const float* pv = vst + (size_t)(t0 + tid) * 16; float s1 = 0.f, s2 = 0.f;
#pragma unroll
        for (int i = 0; i < 8; ++i) { s1 += pv[2 * i]; s2 += pv[2 * i + 1]; }
        const float mu = s1 * (1.f / 2048.f), var = s2 * (1.f / 2048.f) - mu * mu;
        stt[2 * tid] = mu; stt[2 * tid + 1] = rsqrtf(fmaxf(var, 0.f) + 1e-5f); }
    const int nks = 2 * (tt + 1);
    bf16x8 wf[8];
#pragma unroll
    for (int ks = 0; ks < 8; ++ks) { if (ks < nks) wf[ks] = *(const bf16x8*)(wsb + ((size_t)g * 128 + 32 * tt + l32) * 128 + 16 * ks + 8 * hf); else wf[ks] = (bf16x8){0, 0, 0, 0, 0, 0, 0, 0}; }
    const int ch = tid & 31;
    float gq[8], bq[8];
    { const f32x4 a = *(const f32x4*)(lng + g * 256 + ch * 8), b = *(const f32x4*)(lng + g * 256 + ch * 8 + 4), c = *(const f32x4*)(lnb + g * 256 + ch * 8), d = *(const f32x4*)(lnb + g * 256 + ch * 8 + 4);
#pragma unroll
      for (int i = 0; i < 4; ++i) { gq[i] = a[i]; gq[4 + i] = b[i]; bq[i] = c[i]; bq[4 + i] = d[i]; } }
    __syncthreads();
#pragma unroll
    for (int i = 0; i < 8; ++i) { const int row = (tid >> 5) + 16 * i;
        const u32x4 raw = *(const u32x4*)(z + (size_t)(t0 + row) * 6144 + 2048 + g * 256 + ch * 8);
        const float mu = stt[2 * row], rstd = stt[2 * row + 1];
        float f[8]; f[0] = bflo(raw.x); f[1] = bfhi(raw.x); f[2] = bflo(raw.y); f[3] = bfhi(raw.y); f[4] = bflo(raw.z); f[5] = bfhi(raw.z); f[6] = bflo(raw.w); f[7] = bfhi(raw.w);
#pragma unroll
        for (int e = 0; e < 8; ++e) f[e] = (f[e] - mu) * rstd * gq[e] + bq[e];
        u32x4 w4; w4.x = pk2(f[0], f[1]); w4.y = pk2(f[2], f[3]); w4.z = pk2(f[4], f[5]); w4.w = pk2(f[6], f[7]);
        *(u32x4*)(lds + row * 512 + ((ch ^ fxr(row)) << 4)) = w4; }
    __syncthreads();
    f32x16 acc[4];
#pragma unroll
    for (int mo = 0; mo < 4; ++mo)
#pragma unroll
        for (int r = 0; r < 16; ++r) acc[mo][r] = 0.f;
    const int g_blk = (lane >> 4) & 1, g_q = (lane & 15) >> 2, g_p = lane & 3;
#pragma unroll
    for (int ks = 0; ks < 8; ++ks) {
        if (ks < nks) {
#pragma unroll
            for (int mo = 0; mo < 4; ++mo) {
                const int row0 = 16 * ks + 8 * hf + g_q, row1 = row0 + 4, chx = 4 * (dh * 4 + mo) + 2 * g_blk + (g_p >> 1);
                const s16x4 lo = __builtin_amdgcn_ds_read_tr16_b64_v4i16((__attribute__((address_space(3))) s16x4*)(lds + row0 * 512 + ((chx ^ fxr(row0)) << 4) + 8 * (g_p & 1)));
                const s16x4 hi = __builtin_amdgcn_ds_read_tr16_b64_v4i16((__attribute__((address_space(3))) s16x4*)(lds + row1 * 512 + ((chx ^ fxr(row1)) << 4) + 8 * (g_p & 1)));
                const bf16x8 vf = {lo[0], lo[1], lo[2], lo[3], hi[0], hi[1], hi[2], hi[3]};
                acc[mo] = __builtin_amdgcn_mfma_f32_32x32x16_bf16(vf, wf[ks], acc[mo], 0, 0, 0);
            }
        }
    }
    const float bsv = bs[g * 128 + 32 * tt + l32];
    bf16_t* rowp = z + (size_t)(t0 + 32 * tt + l32) * 6144 + g * 256;
#pragma unroll
    for (int mo = 0; mo < 4; ++mo)
#pragma unroll
        for (int rq = 0; rq < 4; ++rq) { const int d = (dh * 4 + mo) * 32 + 8 * rq + 4 * hf;
            const u32x2 uw = *(const u32x2*)(rowp + d), gw = *(const u32x2*)(rowp + 4096 + d);
            f32x4 v;
            v[0] = bflo(uw.x) * (acc[mo][4 * rq + 0] + bsv) * siluf_(bflo(gw.x)); v[1] = bfhi(uw.x) * (acc[mo][4 * rq + 1] + bsv) * siluf_(bfhi(gw.x));
            v[2] = bflo(uw.y) * (acc[mo][4 * rq + 2] + bsv) * siluf_(bflo(gw.y)); v[3] = bfhi(uw.y) * (acc[mo][4 * rq + 3] + bsv) * siluf_(bfhi(gw.y));
            st_bf4(rowp + d, v); }
}

DI float wave_sum(float v) {
#pragma unroll
    for (int o = 32; o > 0; o >>= 1) v += __shfl_xor(v, o);
    return v;
}

__global__ __launch_bounds__(512) void mega_fwd(Params P) {
    extern __shared__ __attribute__((aligned(16))) char lds[];
    cg::grid_group grid = cg::this_grid();
    char* ws = P.ws;
    bf16_t* XB = (bf16_t*)(ws + OFF_XB); bf16_t* BIG = (bf16_t*)(ws + OFF_BIG); bf16_t* WIN = (bf16_t*)(ws + OFF_WIN);
    bf16_t* WOA = (bf16_t*)(ws + OFF_WOA); bf16_t* WOS = (bf16_t*)(ws + OFF_WOS); bf16_t* WP = (bf16_t*)(ws + OFF_WP); bf16_t* WG = (bf16_t*)(ws + OFF_WG);
    bf16_t* PB = (bf16_t*)(ws + OFF_PB); float* SS = (float*)(ws + OFF_SS); float* VST = (float*)(ws + OFF_VST); bf16_t* WSB = (bf16_t*)(ws + OFF_WSB);
    float* XR = P.out;
    const int G = gridDim.x;

    for (int jl = 0; jl < 2; ++jl) {
        conv_T(P.attn_w_out + (size_t)jl * 1024 * 1024, 1024, 1024, WOA + (size_t)jl * 1024 * 1024, nullptr, 0, 1.f, lds);
        conv_T(P.sgu_w_out + (size_t)jl * 2048 * 1024, 2048, 1024, WOS + (size_t)jl * 1024 * 2048, nullptr, 0, 1.f, lds);
    }
    for (int i = 0; i < 4; ++i) {
        conv_T(P.ple_proj + (size_t)i * 256 * 1024, 256, 1024, WP + (size_t)i * 1024 * 256, nullptr, 0, 1.f, lds);
        conv_T(P.ple_gate + (size_t)i * 1024 * 1024, 1024, 1024, WG + (size_t)i * 1024 * 1024, nullptr, 0, 1.f, lds);
    }
    conv_T(P.attn_w_in, 1024, 4096, WIN, P.attn_norm, 1024, 0.125f * LOG2E, lds);
    { const int tid = otid();
    for (size_t e = (size_t)blockIdx.x * 512 + tid; e < (size_t)2 * 8 * 128 * 128; e += (size_t)G * 512) {
        const int s = (int)(e & 127), t = (int)((e >> 7) & 127);
        WSB[e] = (s <= t) ? f2bf(P.w_s[e]) : (bf16_t)0;
    } }
    { const int tid = otid(), wid = tid >> 6, lane = tid & 63;
    for (int row = blockIdx.x * 8 + wid; row < T_; row += G * 8) {
        const float* xr = P.x + (size_t)row * 1024; float sq = 0.f;
#pragma unroll
        for (int i = 0; i < 4; ++i) { const f32x4 v = *(const f32x4*)(xr + i * 256 + lane * 4); sq += (v[0] * v[0] + v[1] * v[1]) + (v[2] * v[2] + v[3] * v[3]);
            st_bf4(XB + (size_t)row * 1024 + i * 256 + lane * 4, v); }
        sq = wave_sum(sq);
        if (lane == 0) *(f32x4*)(SS + (size_t)row * 4) = (f32x4){sq, 0.f, 0.f, 0.f};
    } }
    grid.sync();

    for (int layer = 0; layer < 4; ++layer) {
        const int jl = layer >> 1;
        const bool is_attn = (layer & 1) == 0;
        const float* xin = (layer == 0) ? P.x : XR;
        conv_flat(P.p + (size_t)layer * T_ * 256, PB, (size_t)T_ * 256);
        if (is_attn) {
            { EpiQKVG epi{BIG, SS}; gemm_phase(XB, 1024, WIN, 1024, 1024, 128, 16, lds, epi, 0, 2048); }
            grid.sync();
            {
                float lam; const int lane = otid() & 63;
                { const float a = (lane < 64) ? P.lq1[jl * 64 + lane] * P.lk1[jl * 64 + lane] : 0.f, b2 = P.lq2[jl * 64 + lane] * P.lk2[jl * 64 + lane];
                  lam = __expf(wave_sum(a)) - __expf(wave_sum(b2)) + (layer == 0 ? P.lam_init0 : P.lam_init2); }
                const float oscale = 1.f - (layer == 0 ? P.lam_init0 : P.lam_init2);
                const int xcd = blockIdx.x & 7, slot = blockIdx.x >> 3;
                if (G == 256) {
                    for (int i = 0; i < 4; ++i) {
                        const int bh = i * 16 + xcd * 2 + (slot >> 4), pq = slot & 15;
                        const int b = bh >> 3, h = bh & 7;
                        const float slope2 = exp2f(-(float)(h + 1)) * LOG2E;
                        attn_unit(BIG, b, h, 31 - pq, lam, slope2, P.subln + jl * 128, oscale, lds);
                        attn_unit(BIG, b, h, pq, lam, slope2, P.subln + jl * 128, oscale, lds);
                    }
                } else {
                    for (int u = blockIdx.x; u < 2048; u += G) {
                        const int bh = u >> 5, qb = 31 - (u & 31); const int b = bh >> 3, h = bh & 7;
                        const float slope2 = exp2f(-(float)(h + 1)) * LOG2E;
                        attn_unit(BIG, b, h, qb, lam, slope2, P.subln + jl * 128, oscale, lds);
                    }
                }
            }
            grid.sync();
            { EpiRes epi{xin, XR, BIG + 2048, 4096}; gemm_phase(BIG, 4096, WOA + (size_t)jl * 1024 * 1024, 1024, 1024, 128, 4, lds, epi, 0, 1024); }
            { EpiE epi{BIG + 1024, 4096}; gemm_phase(PB, 256, WP + (size_t)layer * 1024 * 256, 256, 256, 128, 4, lds, epi, 512, 1024); }
            grid.sync();
            if (layer + 1 < 4) conv_T(P.sgu_w_in + (size_t)jl * 1024 * 6144, 1024, 6144, WIN, P.sgu_norm + jl * 1024, 0, 1.f, lds);
            { EpiGate epi{XR, BIG + 1024, 4096, XB, SS}; gemm_phase(BIG + 2048, 4096, WG + (size_t)layer * 1024 * 1024, 1024, 1024, 128, 4, lds, epi, 0, 512); }
            grid.sync();
        } else {
            { EpiSguIn epi{BIG, SS, VST}; gemm_phase(XB, 1024, WIN, 1024, 1024, 128, 24, lds, epi, 0, 3072); }
            grid.sync();
            for (int u = blockIdx.x; u < 2048; u += G) {
                sgu_unit(BIG, u >> 3, u & 7, WSB + (size_t)jl * 8 * 128 * 128, P.b_s + jl * 8 * 128, P.ln_g + jl * 2048, P.ln_b + jl * 2048, VST, lds);
            }
            grid.sync();
            { EpiRes epi{xin, XR, BIG + 4096, 6144}; gemm_phase(BIG, 6144, WOS + (size_t)jl * 1024 * 2048, 2048, 2048, 128, 4, lds, epi, 0, 1024); }
            { EpiE epi{BIG + 2048, 6144}; gemm_phase(PB, 256, WP + (size_t)layer * 1024 * 256, 256, 256, 128, 4, lds, epi, 512, 1024); }
            grid.sync();
            if (layer + 1 < 4) conv_T(P.attn_w_in + (size_t)(jl + 1) * 1024 * 4096, 1024, 4096, WIN, P.attn_norm + (jl + 1) * 1024, 1024, 0.125f * LOG2E, lds);
            { EpiGate epi{XR, BIG + 2048, 6144, XB, SS}; gemm_phase(BIG + 4096, 6144, WG + (size_t)layer * 1024 * 1024, 1024, 1024, 128, 4, lds, epi, 0, 512); }
            grid.sync();
        }
    }
    const int tid = otid(), wid = tid >> 6, lane = tid & 63;
    for (int row = blockIdx.x * 8 + wid; row < T_; row += G * 8) {
        const float rs = rs_from_ss(SS, row);
        float* xr = XR + (size_t)row * 1024;
#pragma unroll
        for (int i = 0; i < 4; ++i) { const int c = i * 256 + lane * 4; const f32x4 v = *(const f32x4*)(xr + c), gg = *(const f32x4*)(P.final_norm + c);
            *(f32x4*)(xr + c) = v * rs * gg; }
    }
}

extern "C" void kernel_launch(void* const* d_in, const int* in_sizes, int n_in, void* d_out, int out_size, void* d_ws, size_t ws_size, hipStream_t stream) {
    static int grid_blocks = 0;
    if (!grid_blocks) {
        int dev = 0, cus = 0, per_cu = 0;
        hipGetDevice(&dev);
        hipDeviceGetAttribute(&cus, hipDeviceAttributeMultiprocessorCount, dev);
        hipFuncSetAttribute((const void*)mega_fwd, hipFuncAttributeMaxDynamicSharedMemorySize, LDS_BYTES);
        hipOccupancyMaxActiveBlocksPerMultiprocessor(&per_cu, mega_fwd, 512, LDS_BYTES);
        if (per_cu < 1) per_cu = 1;
        grid_blocks = cus * 1;
    }
    Params P{};
    const float** pp = (const float**)&P;
    for (int i = 0; i < 20; ++i) pp[i] = (const float*)d_in[i];
    P.out = (float*)d_out; P.ws = (char*)d_ws;
    P.lam_init0 = 0.2f; P.lam_init2 = (float)(0.8 - 0.6 * 0.54881163609402643);
    void* args[] = {&P};
    hipError_t e = hipLaunchCooperativeKernel((void*)mega_fwd, dim3(grid_blocks), dim3(512), args, LDS_BYTES, stream);
    if (e != hipSuccess) fprintf(stderr, "cooperative launch failed: %s (grid %d)\n", hipGetErrorString(e), grid_blocks);
}
```

```cpp
#include <hip/hip_runtime.h>
#include <hip/hip_cooperative_groups.h>
#include <cstdio>
#include <cstdint>
namespace cg = cooperative_groups;

#define DI __device__ __forceinline__
typedef unsigned short bf16_t;
typedef short bf16x8 __attribute__((ext_vector_type(8)));
typedef short s16x4 __attribute__((ext_vector_type(4)));
typedef float f32x2 __attribute__((ext_vector_type(2)));
typedef float f32x4 __attribute__((ext_vector_type(4)));
typedef float f32x16 __attribute__((ext_vector_type(16)));
typedef __bf16 bf16x2v __attribute__((ext_vector_type(2)));
typedef unsigned u32x2 __attribute__((ext_vector_type(2)));
typedef unsigned u32x4 __attribute__((ext_vector_type(4)));

constexpr int T_ = 32768, S_ = 4096;
constexpr size_t MiB = 1024 * 1024;
constexpr size_t OFF_XB = 0, OFF_BIG = 64 * MiB, OFF_WIN = 448 * MiB, OFF_WOA = 460 * MiB, OFF_WOS = 464 * MiB, OFF_WP = 472 * MiB,
                 OFF_WG = 474 * MiB, OFF_PB = 482 * MiB, OFF_SS = 498 * MiB, OFF_VST = 500 * MiB, OFF_WSB = 508 * MiB;
constexpr int LDS_BYTES = 128 * 1024;
#define LOG2E 1.4426950408889634f

struct Params {
    const float *x, *p, *attn_norm, *attn_w_in, *lq1, *lk1, *lq2, *lk2, *subln, *attn_w_out, *sgu_norm, *sgu_w_in, *ln_g, *ln_b, *w_s, *b_s,
        *sgu_w_out, *ple_proj, *ple_gate, *final_norm;
    float* out;
    char* ws;
    float lam_init0, lam_init2;
};

DI int otid() { int t = threadIdx.x; asm volatile("" : "+v"(t)); return t; }
DI unsigned pk2(float a, float b) { f32x2 v = {a, b}; return __builtin_bit_cast(unsigned, __builtin_convertvector(v, bf16x2v)); }
DI bf16_t f2bf(float a) { return (bf16_t)(pk2(a, 0.f) & 0xffffu); }
DI float bflo(unsigned u) { return __uint_as_float(u << 16); }
DI float bfhi(unsigned u) { return __uint_as_float(u & 0xffff0000u); }
DI float sigmoidf_(float x) { return __builtin_amdgcn_rcpf(1.f + __builtin_amdgcn_exp2f(-x * LOG2E)); }
DI float siluf_(float x) { return x * sigmoidf_(x); }
DI f32x2 gelu_pk(f32x2 v) {
    const f32x2 av = __builtin_elementwise_abs(v), d = av * 0.2316418882f + 1.0f;
    f32x2 t; t.x = __builtin_amdgcn_rcpf(d.x); t.y = __builtin_amdgcn_rcpf(d.y);
    f32x2 q = t * 0.5307027145f + (-0.7265760135f); q = q * t + 0.7107068705f; q = q * t + (-0.142248368f); q = q * t + 0.127414796f; q = q * t;
    const f32x2 s = (v * v) * (-0.72134752044f);
    f32x2 e; e.x = __builtin_amdgcn_exp2f(s.x); e.y = __builtin_amdgcn_exp2f(s.y);
    const f32x2 m = v * (q * e), r = v - m;
    f32x2 o; o.x = v.x < 0.f ? m.x : r.x; o.y = v.y < 0.f ? m.y : r.y; return o;
}
DI int fxr(int row) { return ((row & 3) << 2) | ((row >> 2) & 3); }

DI void conv_T(const float* src, int K, int N, bf16_t* dst, const float* gain, int nscale, float cs, char* ldsc) {
    float* lds = (float*)ldsc;
    const int tilesN = N / 64, ntile = (K / 64) * tilesN;
    for (int ti = blockIdx.x; ti < ntile; ti += gridDim.x) {
        const int tk = ti / tilesN, tn = ti % tilesN; const int tx = otid();
        __syncthreads();
#pragma unroll
        for (int i = 0; i < 8; ++i) {
            const int e = tx + i * 512, kk = e >> 6, nn = e & 63;
            float v = src[(size_t)(tk * 64 + kk) * N + tn * 64 + nn];
            if (gain) v *= gain[tk * 64 + kk];
            if (tn * 64 + nn < nscale) v *= cs;
            lds[kk * 65 + nn] = v;
        }
        __syncthreads();
#pragma unroll
        for (int i = 0; i < 8; ++i) {
            const int e = tx + i * 512, nn = e >> 6, kk = e & 63;
            dst[(size_t)(tn * 64 + nn) * K + tk * 64 + kk] = f2bf(lds[kk * 65 + nn]);
        }
    }
}
DI void conv_flat(const float* src, bf16_t* dst, size_t n) {
    const size_t nch = n / 8;
    const int tx = otid();
    for (size_t c = (size_t)blockIdx.x * 512 + tx; c < nch; c += (size_t)gridDim.x * 512) {
        const f32x4 a = *(const f32x4*)(src + c * 8), b = *(const f32x4*)(src + c * 8 + 4);
        u32x4 w; w.x = pk2(a[0], a[1]); w.y = pk2(a[2], a[3]); w.z = pk2(b[0], b[1]); w.w = pk2(b[2], b[3]);
        *(u32x4*)(dst + c * 8) = w;
    }
}

typedef __attribute__((address_space(3))) unsigned char lds_uc;
constexpr int HTB = 128 * 64 * 2;
DI int lds_byte(int r, int c) { const int st = (r >> 4) * 2 + (c >> 5), rr = r & 15, cc = c & 31, ob = rr * 64 + cc * 2; return st * 1024 + (ob ^ (((ob >> 9) & 1) << 5)); }
DI void stage_rc(int b, int& R, int& C) { const int st = b / 1024, sb = b % 1024, swz = sb ^ (((sb >> 9) & 1) << 5); R = (st >> 1) * 16 + swz / 64; C = (st & 1) * 32 + (swz % 64) / 2; }
struct Unit { int pm, pn; };
struct StaticOrder {
    int nM, nN, nwg, G, c;
    DI void init(int M, int N, int G_, int c_) { nM = M / 256; nN = N / 256; nwg = nM * nN; G = G_; c = c_; }
    DI bool next(int i, Unit& u) const {
        const long L = (long)i * G + c; if (L >= nwg) return false;
        int wgid = (int)L; { const int q = nwg / 8, r = nwg % 8, xcd = wgid % 8, off = wgid / 8; wgid = (xcd < r ? xcd * (q + 1) : r * (q + 1) + (xcd - r) * q) + off; }
        const int nig = 8 * nN, gid = wgid / nig, fm = gid * 8, gsz = (nM - fm) < 8 ? (nM - fm) : 8;
        u.pm = fm + ((wgid % nig) % gsz); u.pn = (wgid % nig) / gsz; return true;
    }
};

template <class Epi>
DI void gemm_phase(char* lds_generic, const bf16_t* A, int lda, const bf16_t* Bt, int ldb, int K, int M, int N, const Epi& E) {
    lds_uc* lds = (lds_uc*)lds_generic;
    const int tid = otid(), wid = __builtin_amdgcn_readfirstlane(tid >> 6), lane = tid & 63, wr = wid >> 2, wc = wid & 3, fr = lane & 15, fq = lane >> 4;
    StaticOrder S; S.init(M, N, gridDim.x, blockIdx.x);
    const int nt = K / 64;
    unsigned voffA[2], voffB[2];
#pragma unroll
    for (int i = 0; i < 2; ++i) { int R, C; stage_rc(tid * 16 + i * 8192, R, C); voffA[i] = (unsigned)(R * lda + C) * 2u; voffB[i] = (unsigned)(R * ldb + C) * 2u; }
    const size_t kstep = 128;
    const size_t hstepA = (size_t)128 * lda * 2, hstepB = (size_t)128 * ldb * 2, tstepA = 2 * hstepA, tstepB = 2 * hstepB;
    const unsigned ldsw = (unsigned)wid * 1024u;
    const int aoff = lds_byte(wr * 64 + fr, fq * 8), boff = lds_byte(wc * 32 + fr, fq * 8);
#define PG8_SA(b, h) (((b) * 2 + (h)) * HTB)
#define PG8_SB(b, h) ((4 + (b) * 2 + (h)) * HTB)
#define PG8_STAGE(bufoff, gbase, voff) do { _Pragma("unroll") for (int _i = 0; _i < 2; ++_i) \
        __builtin_amdgcn_global_load_lds((const unsigned*)((const char*)(gbase) + (voff)[_i]), (__attribute__((address_space(3))) unsigned*)(lds + (bufoff) + ldsw + _i * 8192), 16, 0, 0); } while (0)
#define PG8_LDA(dst, b, h) do { _Pragma("unroll") for (int m = 0; m < 4; ++m) _Pragma("unroll") for (int k = 0; k < 2; ++k) dst[m][k] = *(const __attribute__((address_space(3))) bf16x8*)(lds + PG8_SA(b, h) + aoff + m * 2048 + k * 1024); } while (0)
#define PG8_LDB(dst, b, h) do { _Pragma("unroll") for (int n = 0; n < 2; ++n) _Pragma("unroll") for (int k = 0; k < 2; ++k) dst[n][k] = *(const __attribute__((address_space(3))) bf16x8*)(lds + PG8_SB(b, h) + boff + n * 2048 + k * 1024); } while (0)
#define PG8_MMA(ai, bj, At, Bt_) do { __builtin_amdgcn_s_setprio(1); _Pragma("unroll") for (int m = 0; m < 4; ++m) _Pragma("unroll") for (int n = 0; n < 2; ++n) _Pragma("unroll") for (int k = 0; k < 2; ++k) \
        acc[ai][bj][m][n] = __builtin_amdgcn_mfma_f32_16x16x32_bf16(Bt_[n][k], At[m][k], acc[ai][bj][m][n], 0, 0, 0); __builtin_amdgcn_s_setprio(0); } while (0)
#define PG8_WAIT_V(n) asm volatile("s_waitcnt vmcnt(" #n ")" ::: "memory")
#define PG8_WAIT_L(n) asm volatile("s_waitcnt lgkmcnt(" #n ")" ::: "memory")
#define PG8_BAR __builtin_amdgcn_s_barrier()
#define PG8_SCHED __builtin_amdgcn_sched_barrier(0)
    Unit cur, nxt; int ui = 0;
    __syncthreads();
    if (!S.next(0, cur)) return;
    PG8_WAIT_V(0);
    f32x4 acc[2][2][4][2];
#pragma unroll
    for (int a = 0; a < 2; ++a)
#pragma unroll
        for (int b = 0; b < 2; ++b)
#pragma unroll
            for (int m = 0; m < 4; ++m)
#pragma unroll
                for (int n = 0; n < 2; ++n) acc[a][b][m][n] = (f32x4){0.f, 0.f, 0.f, 0.f};
    bf16x8 At[4][2], B0[2][2], B1[2][2];
    const char* cA = (const char*)A + (size_t)cur.pm * tstepA; const char* cB = (const char*)Bt + (size_t)cur.pn * tstepB;
    PG8_STAGE(PG8_SB(0, 0), cB, voffB); PG8_STAGE(PG8_SA(0, 0), cA, voffA); PG8_STAGE(PG8_SB(0, 1), cB + hstepB, voffB); PG8_STAGE(PG8_SA(0, 1), cA + hstepA, voffA);
    if (wr == 1) PG8_BAR;
    PG8_WAIT_V(4); PG8_BAR;
    PG8_STAGE(PG8_SB(1, 0), cB + kstep, voffB); PG8_STAGE(PG8_SA(1, 0), cA + kstep, voffA); PG8_STAGE(PG8_SB(1, 1), cB + hstepB + kstep, voffB);
    PG8_WAIT_V(6); PG8_BAR;
    for (;;) {
        const bool has_next = S.next(ui + 1, nxt);
        const char* nA = has_next ? (const char*)A + (size_t)nxt.pm * tstepA : cA; const char* nB = has_next ? (const char*)Bt + (size_t)nxt.pn * tstepB : cB;
#pragma unroll 1
        for (int t = 0; t < nt; t += 2) {
            const bool last = (t == nt - 2);
            const char* a1 = cA + (size_t)(t + 1) * kstep;
            const char* a2 = last ? nA : cA + (size_t)(t + 2) * kstep; const char* b2 = last ? nB : cB + (size_t)(t + 2) * kstep;
            const char* a3 = a2 + kstep; const char* b3 = b2 + kstep;
            PG8_LDB(B0, 0, 0); PG8_SCHED; PG8_LDA(At, 0, 0); PG8_STAGE(PG8_SA(1, 1), a1 + hstepA, voffA);
            PG8_WAIT_L(8); PG8_BAR; PG8_WAIT_L(0); PG8_MMA(0, 0, At, B0); PG8_BAR; PG8_SCHED;
            PG8_LDB(B1, 0, 1); PG8_STAGE(PG8_SB(0, 0), b2, voffB);
            PG8_BAR; PG8_WAIT_L(0); PG8_MMA(0, 1, At, B1); PG8_BAR;
            PG8_LDA(At, 0, 1); PG8_STAGE(PG8_SA(0, 0), a2, voffA);
            PG8_BAR; PG8_WAIT_L(0); PG8_MMA(1, 0, At, B0); PG8_BAR; PG8_SCHED;
            PG8_STAGE(PG8_SB(0, 1), b2 + hstepB, voffB);
            PG8_WAIT_V(6); PG8_BAR; PG8_MMA(1, 1, At, B1); PG8_BAR;
            PG8_LDB(B0, 1, 0); PG8_SCHED; PG8_LDA(At, 1, 0); PG8_STAGE(PG8_SA(0, 1), a2 + hstepA, voffA);
            PG8_WAIT_L(8); PG8_BAR; PG8_WAIT_L(0); PG8_MMA(0, 0, At, B0); PG8_BAR; PG8_SCHED;
            PG8_LDB(B1, 1, 1); PG8_STAGE(PG8_SB(1, 0), b3, voffB);
            PG8_BAR; PG8_WAIT_L(0); PG8_MMA(0, 1, At, B1); PG8_BAR;
            PG8_LDA(At, 1, 1); PG8_STAGE(PG8_SA(1, 0), a3, voffA);
            PG8_BAR; PG8_WAIT_L(0); PG8_MMA(1, 0, At, B0); PG8_BAR; PG8_SCHED;
            PG8_STAGE(PG8_SB(1, 1), b3 + hstepB, voffB);
            PG8_WAIT_V(6); PG8_BAR; PG8_MMA(1, 1, At, B1); PG8_BAR;
        }
        E(acc, cur.pm, cur.pn, wr, wc, fr, fq);
        if (!has_next) break;
#pragma unroll
        for (int a = 0; a < 2; ++a)
#pragma unroll
            for (int b = 0; b < 2; ++b)
#pragma unroll
                for (int m = 0; m < 4; ++m)
#pragma unroll
                    for (int n = 0; n < 2; ++n) acc[a][b][m][n] = (f32x4){0.f, 0.f, 0.f, 0.f};
        cur = nxt; cA = nA; cB = nB; ++ui;
    }
    PG8_WAIT_V(0);
    if (wr == 0) PG8_BAR;
    PG8_BAR;
}

#define EPI_ARGS const f32x4 (&acc)[2][2][4][2], int pm, int pn, int wr, int wc, int fr, int fq
#define ROW_OF(ai, m) (pm * 256 + (ai) * 128 + wr * 64 + (m) * 16 + fr)
#define COL_OF(bj, n) (pn * 256 + (bj) * 128 + wc * 32 + (n) * 16 + fq * 4)
DI float rs_from_ss(const float* ss, int row) {
    const f32x4* p = (const f32x4*)(ss + (size_t)row * 16); const f32x4 s = (p[0] + p[1]) + (p[2] + p[3]);
    return rsqrtf(((s[0] + s[1]) + (s[2] + s[3])) * (1.f / 1024.f) + 1e-6f); }
DI void st_bf4(bf16_t* p, f32x4 v) { u32x2 w; w.x = pk2(v[0], v[1]); w.y = pk2(v[2], v[3]); *(u32x2*)p = w; }
DI float quad_sum(float v) { v += __shfl_xor(v, 16); v += __shfl_xor(v, 32); return v; }

struct EpiQKVG {
    bf16_t* out; const float* ss;
    DI void operator()(EPI_ARGS) const {
#pragma unroll
        for (int ai = 0; ai < 2; ++ai)
#pragma unroll
            for (int m = 0; m < 4; ++m) { const int row = ROW_OF(ai, m); const float rs = rs_from_ss(ss, row);
#pragma unroll
                for (int bj = 0; bj < 2; ++bj)
#pragma unroll
                    for (int n = 0; n < 2; ++n) st_bf4(out + (size_t)row * 4096 + COL_OF(bj, n), acc[ai][bj][m][n] * rs); }
    }
};
struct EpiSguIn {
    bf16_t* z; const float* ss; float* vst;
    DI void operator()(EPI_ARGS) const {
        const bool do_gelu = pn < 16, do_stats = (pn >= 8) && (pn < 16);
#pragma unroll
        for (int ai = 0; ai < 2; ++ai)
#pragma unroll
            for (int m = 0; m < 4; ++m) { const int row = ROW_OF(ai, m); const float rs = rs_from_ss(ss, row); float s1 = 0.f, s2 = 0.f;
#pragma unroll
                for (int bj = 0; bj < 2; ++bj)
#pragma unroll
                    for (int n = 0; n < 2; ++n) { f32x4 v = acc[ai][bj][m][n] * rs;
                        if (do_gelu) { const f32x2 a = gelu_pk((f32x2){v[0], v[1]}), b = gelu_pk((f32x2){v[2], v[3]}); v = (f32x4){a.x, a.y, b.x, b.y}; }
                        s1 += (v[0] + v[1]) + (v[2] + v[3]); s2 += (v[0] * v[0] + v[1] * v[1]) + (v[2] * v[2] + v[3] * v[3]);
                        st_bf4(z + (size_t)row * 6144 + COL_OF(bj, n), v); }
                if (do_stats) { s1 = quad_sum(s1); s2 = quad_sum(s2);
                    if (fq == 0) *(f32x2*)(vst + ((size_t)row * 32 + (pn - 8) * 4 + wc) * 2) = (f32x2){s1, s2}; } }
    }
};
struct EpiRes {
    const float* xin; float* xr; bf16_t* xb; int ldxb;
    DI void operator()(EPI_ARGS) const {
#pragma unroll
        for (int ai = 0; ai < 2; ++ai)
#pragma unroll
            for (int m = 0; m < 4; ++m) { const int row = ROW_OF(ai, m);
#pragma unroll
                for (int bj = 0; bj < 2; ++bj)
#pragma unroll
                    for (int n = 0; n < 2; ++n) { const int col = COL_OF(bj, n); const f32x4 v = *(const f32x4*)(xin + (size_t)row * 1024 + col) + acc[ai][bj][m][n];
                        *(f32x4*)(xr + (size_t)row * 1024 + col) = v; st_bf4(xb + (size_t)row * ldxb + col, v); } }
    }
};
struct EpiE {
    bf16_t* e; int lde;
    DI void operator()(EPI_ARGS) const {
#pragma unroll
        for (int ai = 0; ai < 2; ++ai)
#pragma unroll
            for (int m = 0; m < 4; ++m) { const int row = ROW_OF(ai, m);
#pragma unroll
                for (int bj = 0; bj < 2; ++bj)
#pragma unroll
                    for (int n = 0; n < 2; ++n) st_bf4(e + (size_t)row * lde + COL_OF(bj, n), acc[ai][bj][m][n]); }
    }
};
struct EpiGate {
    float* xr; const bf16_t* e; int lde; bf16_t* xb; float* ss;
    DI void operator()(EPI_ARGS) const {
#pragma unroll
        for (int ai = 0; ai < 2; ++ai)
#pragma unroll
            for (int m = 0; m < 4; ++m) { const int row = ROW_OF(ai, m); float s2 = 0.f;
#pragma unroll
                for (int bj = 0; bj < 2; ++bj)
#pragma unroll
                    for (int n = 0; n < 2; ++n) { const int col = COL_OF(bj, n);
                        const f32x4 xm = *(const f32x4*)(xr + (size_t)row * 1024 + col); const u32x2 ew = *(const u32x2*)(e + (size_t)row * lde + col);
                        const f32x4 g = acc[ai][bj][m][n]; f32x4 v;
                        v[0] = xm[0] + bflo(ew.x) * sigmoidf_(g[0]); v[1] = xm[1] + bfhi(ew.x) * sigmoidf_(g[1]);
                        v[2] = xm[2] + bflo(ew.y) * sigmoidf_(g[2]); v[3] = xm[3] + bfhi(ew.y) * sigmoidf_(g[3]);
                        s2 += (v[0] * v[0] + v[1] * v[1]) + (v[2] * v[2] + v[3] * v[3]);
                        *(f32x4*)(xr + (size_t)row * 1024 + col) = v; st_bf4(xb + (size_t)row * 1024 + col, v); }
                s2 = quad_sum(s2);
                if (fq == 0) ss[(size_t)row * 16 + pn * 4 + wc] = s2; }
    }
};

DI void attn_unit(bf16_t* big, int b, int h, int qb, float lam, float slope2, const float* subln_g, float oscale, char* lds) {
    int tid_ = threadIdx.x; asm volatile("" : "+v"(tid_));
    const int tid = tid_, wid = tid >> 6, lane = tid & 63, w = wid & 3, j = wid >> 2, hf = lane >> 5, l32 = lane & 31;
    const int q0 = qb * 128;
    const size_t rowbase = (size_t)b * S_;
    const float NEG_INF = -__builtin_inff();
    bf16x8 qf[4];
    { const bf16_t* Qp = big + (rowbase + q0 + 32 * w + l32) * 4096 + h * 128 + j * 64;
#pragma unroll
      for (int ks = 0; ks < 4; ++ks) qf[ks] = *(const bf16x8*)(Qp + 16 * ks + 8 * hf); }
    f32x16 o[4];
#pragma unroll
    for (int mo = 0; mo < 4; ++mo)
#pragma unroll
        for (int r = 0; r < 16; ++r) o[mo][r] = 0.f;
    float m_run = NEG_INF, l_run = 0.f;
    const int nkt = 2 * qb + 2;
    const bf16_t* Kg = big + rowbase * 4096 + 1024 + h * 128;
    const bf16_t* Vg = big + rowbase * 4096 + 2048 + h * 128;
    u32x4 rg[4];
    auto load_tile = [&](int kt) {
        const size_t key = (size_t)kt * 64 + (tid >> 3);
        rg[0] = *(const u32x4*)(Kg + key * 4096 + (tid & 7) * 8);
        rg[1] = *(const u32x4*)(Kg + key * 4096 + 64 + (tid & 7) * 8);
#pragma unroll
        for (int i = 0; i < 2; ++i) { const int c = tid + 512 * i; const size_t k2 = (size_t)kt * 64 + (c >> 4); rg[2 + i] = *(const u32x4*)(Vg + k2 * 4096 + (c & 15) * 8); }
    };
    auto store_tile = [&](char* buf) {
        { const int row = tid >> 3, ch = tid & 7; const int o_ = row * 128 + ((ch ^ (row & 7)) << 4);
          *(u32x4*)(buf + o_) = rg[0]; *(u32x4*)(buf + 8192 + o_) = rg[1]; }
#pragma unroll
        for (int i = 0; i < 2; ++i) { const int c = tid + 512 * i, row = c >> 4, ch = c & 15; *(u32x4*)(buf + 16384 + row * 256 + ((ch ^ fxr(row)) << 4)) = rg[2 + i]; }
    };
    __syncthreads();
    load_tile(nkt - 1);
    store_tile(lds);
    __syncthreads();
    const int g_blk = (lane >> 4) & 1, g_q = (lane & 15) >> 2, g_p = lane & 3;
    int it = 0;
    for (int kt = nkt - 1; kt >= 0; --kt, ++it) {
        char* buf = lds + (it & 1) * 32768;
        char* nbuf = lds + ((it + 1) & 1) * 32768;
        if (kt > 0) load_tile(kt - 1);
        const bool skip = (64 * kt > q0 + 32 * w + 31);
        if (!skip) {
            const char* kb = buf + j * 8192; const char* vb = buf + 16384;
            f32x16 st[2];
#pragma unroll
            for (int mt = 0; mt < 2; ++mt) {
#pragma unroll
                for (int r = 0; r < 16; ++r) st[mt][r] = 0.f;
#pragma unroll
                for (int ks = 0; ks < 4; ++ks) { const int row = 32 * mt + l32, ch = 2 * ks + hf;
                    const bf16x8 kf = *(const bf16x8*)(kb + row * 128 + ((ch ^ (row & 7)) << 4));
                    st[mt] = __builtin_amdgcn_mfma_f32_32x32x16_bf16(kf, qf[ks], st[mt], 0, 0, 0); }
            }
            __builtin_amdgcn_sched_barrier(0);
            const float kbias = slope2 * (float)(64 * kt - q0 + 4 * hf);
            const bool diag = (64 * kt + 63 > q0 + 32 * w);
            const int qrel = q0 + 32 * w + l32 - 64 * kt - 4 * hf;
            float tm = NEG_INF;
#pragma unroll
            for (int mt = 0; mt < 2; ++mt)
#pragma unroll
                for (int r = 0; r < 16; ++r) { const int ko = 32 * mt + (r & 3) + 8 * (r >> 2);
                    float s = st[mt][r] + (kbias + slope2 * (float)ko);
                    if (diag && ko > qrel) s = NEG_INF;
                    st[mt][r] = s; tm = fmaxf(tm, s); }
            tm = fmaxf(tm, __shfl_xor(tm, 32));
            const float mn = fmaxf(m_run, tm);
            const float alpha = __builtin_amdgcn_exp2f(m_run - mn);
            m_run = mn;
            float ps = 0.f;
#pragma unroll
            for (int mt = 0; mt < 2; ++mt)
#pragma unroll
                for (int r = 0; r < 16; ++r) { const float p = __builtin_amdgcn_exp2f(st[mt][r] - mn); st[mt][r] = p; ps += p; }
            l_run = l_run * alpha + ps;
            if (__any(alpha != 1.f)) {
#pragma unroll
                for (int mo = 0; mo < 4; ++mo)
#pragma unroll
                    for (int r = 0; r < 16; ++r) o[mo][r] *= alpha;
            }
            __builtin_amdgcn_sched_barrier(0);
            bf16x8 pf[4];
#pragma unroll
            for (int kk = 0; kk < 4; ++kk) { const int mt = kk >> 1, s8 = (kk & 1) * 8; u32x4 pw;
                pw.x = pk2(st[mt][s8 + 0], st[mt][s8 + 1]); pw.y = pk2(st[mt][s8 + 2], st[mt][s8 + 3]);
                pw.z = pk2(st[mt][s8 + 4], st[mt][s8 + 5]); pw.w = pk2(st[mt][s8 + 6], st[mt][s8 + 7]);
                pf[kk] = __builtin_bit_cast(bf16x8, pw); }
            __builtin_amdgcn_sched_barrier(0);
#pragma unroll
            for (int mo = 0; mo < 4; ++mo)
#pragma unroll
                for (int kk = 0; kk < 4; ++kk) {
                    const int row0 = 16 * kk + 4 * hf + g_q, row1 = row0 + 8, ch = 4 * mo + 2 * g_blk + (g_p >> 1);
                    const s16x4 lo = __builtin_amdgcn_ds_read_tr16_b64_v4i16((__attribute__((address_space(3))) s16x4*)(vb + row0 * 256 + ((ch ^ fxr(row0)) << 4) + 8 * (g_p & 1)));
                    const s16x4 hi = __builtin_amdgcn_ds_read_tr16_b64_v4i16((__attribute__((address_space(3))) s16x4*)(vb + row1 * 256 + ((ch ^ fxr(row1)) << 4) + 8 * (g_p & 1)));
                    const bf16x8 vf = {lo[0], lo[1], lo[2], lo[3], hi[0], hi[1], hi[2], hi[3]};
                    o[mo] = __builtin_amdgcn_mfma_f32_32x32x16_bf16(vf, pf[kk], o[mo], 0, 0, 0);
                    if (kk == 3) __builtin_amdgcn_sched_barrier(0);
                }
        }
        if (kt > 0) store_tile(nbuf);
        __syncthreads();
    }
    const float l_tot = l_run + __shfl_xor(l_run, 32);
    float inv = 1.f / l_tot; if (j == 1) inv *= lam;
    float* ex = (float*)lds;
    if (j == 1) {
#pragma unroll
        for (int mo = 0; mo < 4; ++mo)
#pragma unroll
            for (int r = 0; r < 16; ++r) ex[(w * 64 + mo * 16 + r) * 64 + lane] = o[mo][r] * inv;
    }
    __syncthreads();
    if (j == 0) {
        float sq = 0.f;
#pragma unroll
        for (int mo = 0; mo < 4; ++mo)
#pragma unroll
            for (int r = 0; r < 16; ++r) { const float v = o[mo][r] * inv - ex[(w * 64 + mo * 16 + r) * 64 + lane]; o[mo][r] = v; sq += v * v; }
        sq += __shfl_xor(sq, 32);
        const float rn = rsqrtf(sq * (1.f / 128.f) + 1e-5f) * oscale;
        bf16_t* rowp = big + (rowbase + q0 + 32 * w + l32) * 4096 + h * 128;
#pragma unroll
        for (int mo = 0; mo < 4; ++mo)
#pragma unroll
            for (int rq = 0; rq < 4; ++rq) { const int dv = 32 * mo + 8 * rq + 4 * hf;
                const u32x2 gw = *(const u32x2*)(rowp + 3072 + dv); const f32x4 sg = *(const f32x4*)(subln_g + dv);
                f32x4 v;
                v[0] = o[mo][4 * rq + 0] * rn * sg[0] * siluf_(bflo(gw.x)); v[1] = o[mo][4 * rq + 1] * rn * sg[1] * siluf_(bfhi(gw.x));
                v[2] = o[mo][4 * rq + 2] * rn * sg[2] * siluf_(bflo(gw.y)); v[3] = o[mo][4 * rq + 3] * rn * sg[3] * siluf_(bfhi(gw.y));
                st_bf4(rowp + dv, v); }
    }
}

DI void sgu_unit(bf16_t* z, int chunk, int g, const bf16_t* wsb, const float* bs, const float* lng, const float* lnb, const float* vst, char* lds) {
    int tid_ = threadIdx.x; asm volatile("" : "+v"(tid_));
    const int tid = tid_, wid = tid >> 6, lane = tid & 63, tt = wid & 3, dh = wid >> 2, hf = lane >> 5, l32 = lane & 31;
    const int t0 = chunk * 128;
    float* stt = (float*)(lds + 65536);
    __syncthreads();
    if (tid < 128) { const f32x4* pv = (const f32x4*)(vst + (size_t)(t0 + tid) * 64); float s1 = 0.f, s2 = 0.f;
#pragma unroll
        for (int i = 0; i < 16; ++i) { const f32x4 q4 = pv[i]; s1 += q4[0] + q4[2]; s2 += q4[1] + q4[3]; }
        const float mu = s1 * (1.f / 2048.f), var = s2 * (1.f / 2048.f) - mu * mu;
        stt[2 * tid] = mu; stt[2 * tid + 1] = rsqrtf(fmaxf(var, 0.f) + 1e-5f); }
    const int nks = 2 * (tt + 1);
    bf16x8 wf[8];
#pragma unroll
    for (int ks = 0; ks < 8; ++ks) { if (ks < nks) wf[ks] = *(const bf16x8*)(wsb + ((size_t)g * 128 + 32 * tt + l32) * 128 + 16 * ks + 8 * hf); else wf[ks] = (bf16x8){0, 0, 0, 0, 0, 0, 0, 0}; }
    const int ch = tid & 31;
    float gq[8], bq[8];
    { const f32x4 a = *(const f32x4*)(lng + g * 256 + ch * 8), b = *(const f32x4*)(lng + g * 256 + ch * 8 + 4), c = *(const f32x4*)(lnb + g * 256 + ch * 8), d = *(const f32x4*)(lnb + g * 256 + ch * 8 + 4);
#pragma unroll
      for (int i = 0; i < 4; ++i) { gq[i] = a[i]; gq[4 + i] = b[i]; bq[i] = c[i]; bq[4 + i] = d[i]; } }
    __syncthreads();
#pragma unroll
    for (int i = 0; i < 8; ++i) { const int row = (tid >> 5) + 16 * i;
        const u32x4 raw = *(const u32x4*)(z + (size_t)(t0 + row) * 6144 + 2048 + g * 256 + ch * 8);
        const float mu = stt[2 * row], rstd = stt[2 * row + 1];
        float f[8]; f[0] = bflo(raw.x); f[1] = bfhi(raw.x); f[2] = bflo(raw.y); f[3] = bfhi(raw.y); f[4] = bflo(raw.z); f[5] = bfhi(raw.z); f[6] = bflo(raw.w); f[7] = bfhi(raw.w);
#pragma unroll
        for (int e = 0; e < 8; ++e) f[e] = (f[e] - mu) * rstd * gq[e] + bq[e];
        u32x4 w4; w4.x = pk2(f[0], f[1]); w4.y = pk2(f[2], f[3]); w4.z = pk2(f[4], f[5]); w4.w = pk2(f[6], f[7]);
        *(u32x4*)(lds + row * 512 + ((ch ^ fxr(row)) << 4)) = w4; }
    __syncthreads();
    f32x16 acc[4];
#pragma unroll
    for (int mo = 0; mo < 4; ++mo)
#pragma unroll
        for (int r = 0; r < 16; ++r) acc[mo][r] = 0.f;
    const int g_blk = (lane >> 4) & 1, g_q = (lane & 15) >> 2, g_p = lane & 3;
#pragma unroll
    for (int ks = 0; ks < 8; ++ks) {
        if (ks < nks) {
#pragma unroll
            for (int mo = 0; mo < 4; ++mo) {
                const int row0 = 16 * ks + 8 * hf + g_q, row1 = row0 + 4, chx = 4 * (dh * 4 + mo) + 2 * g_blk + (g_p >> 1);
                const s16x4 lo = __builtin_amdgcn_ds_read_tr16_b64_v4i16((__attribute__((address_space(3))) s16x4*)(lds + row0 * 512 + ((chx ^ fxr(row0)) << 4) + 8 * (g_p & 1)));
                const s16x4 hi = __builtin_amdgcn_ds_read_tr16_b64_v4i16((__attribute__((address_space(3))) s16x4*)(lds + row1 * 512 + ((chx ^ fxr(row1)) << 4) + 8 * (g_p & 1)));
                const bf16x8 vf = {lo[0], lo[1], lo[2], lo[3], hi[0], hi[1], hi[2], hi[3]};
                acc[mo] = __builtin_amdgcn_mfma_f32_32x32x16_bf16(vf, wf[ks], acc[mo], 0, 0, 0);
            }
        }
    }
    const float bsv = bs[g * 128 + 32 * tt + l32];
    bf16_t* rowp = z + (size_t)(t0 + 32 * tt + l32) * 6144 + g * 256;
#pragma unroll
    for (int mo = 0; mo < 4; ++mo)
#pragma unroll
        for (int rq = 0; rq < 4; ++rq) { const int d = (dh * 4 + mo) * 32 + 8 * rq + 4 * hf;
            const u32x2 uw = *(const u32x2*)(rowp + d), gw = *(const u32x2*)(rowp + 4096 + d);
            f32x4 v;
            v[0] = bflo(uw.x) * (acc[mo][4 * rq + 0] + bsv) * siluf_(bflo(gw.x)); v[1] = bfhi(uw.x) * (acc[mo][4 * rq + 1] + bsv) * siluf_(bfhi(gw.x));
            v[2] = bflo(uw.y) * (acc[mo][4 * rq + 2] + bsv) * siluf_(bflo(gw.y)); v[3] = bfhi(uw.y) * (acc[mo][4 * rq + 3] + bsv) * siluf_(bfhi(gw.y));
            st_bf4(rowp + d, v); }
}

DI float wave_sum(float v) {
#pragma unroll
    for (int o = 32; o > 0; o >>= 1) v += __shfl_xor(v, o);
    return v;
}

__global__ __launch_bounds__(512) void mega_fwd(Params P) {
    extern __shared__ __attribute__((aligned(16))) char lds[];
    cg::grid_group grid = cg::this_grid();
#define WS_PTRS char* ws = P.ws; asm volatile("" : "+s"(ws)); \
    bf16_t* XB = (bf16_t*)(ws + OFF_XB); bf16_t* BIG = (bf16_t*)(ws + OFF_BIG); bf16_t* WIN = (bf16_t*)(ws + OFF_WIN); \
    bf16_t* WOA = (bf16_t*)(ws + OFF_WOA); bf16_t* WOS = (bf16_t*)(ws + OFF_WOS); bf16_t* WP = (bf16_t*)(ws + OFF_WP); bf16_t* WG = (bf16_t*)(ws + OFF_WG); \
    bf16_t* PB = (bf16_t*)(ws + OFF_PB); float* SS = (float*)(ws + OFF_SS); float* VST = (float*)(ws + OFF_VST); bf16_t* WSB = (bf16_t*)(ws + OFF_WSB); \
    (void)XB; (void)BIG; (void)WIN; (void)WOA; (void)WOS; (void)WP; (void)WG; (void)PB; (void)SS; (void)VST; (void)WSB;
    float* XR = P.out;
    const int G = gridDim.x;
    {
    WS_PTRS

    for (int jl = 0; jl < 2; ++jl) {
        conv_T(P.attn_w_out + (size_t)jl * 1024 * 1024, 1024, 1024, WOA + (size_t)jl * 1024 * 1024, nullptr, 0, 1.f, lds);
        conv_T(P.sgu_w_out + (size_t)jl * 2048 * 1024, 2048, 1024, WOS + (size_t)jl * 1024 * 2048, nullptr, 0, 1.f, lds);
    }
    for (int i = 0; i < 4; ++i) {
        conv_T(P.ple_proj + (size_t)i * 256 * 1024, 256, 1024, WP + (size_t)i * 1024 * 256, nullptr, 0, 1.f, lds);
        conv_T(P.ple_gate + (size_t)i * 1024 * 1024, 1024, 1024, WG + (size_t)i * 1024 * 1024, nullptr, 0, 1.f, lds);
    }
    conv_T(P.attn_w_in, 1024, 4096, WIN, P.attn_norm, 1024, 0.125f * LOG2E, lds);
    { const int tid = otid();
    for (size_t e = (size_t)blockIdx.x * 512 + tid; e < (size_t)2 * 8 * 128 * 128; e += (size_t)G * 512) {
        const int s = (int)(e & 127), t = (int)((e >> 7) & 127);
        WSB[e] = (s <= t) ? f2bf(P.w_s[e]) : (bf16_t)0;
    } }
    { const int tid = otid(), wid = tid >> 6, lane = tid & 63;
    for (int row = blockIdx.x * 8 + wid; row < T_; row += G * 8) {
        const float* xr = P.x + (size_t)row * 1024; float sq = 0.f;
#pragma unroll
        for (int i = 0; i < 4; ++i) { const f32x4 v = *(const f32x4*)(xr + i * 256 + lane * 4); sq += (v[0] * v[0] + v[1] * v[1]) + (v[2] * v[2] + v[3] * v[3]);
            st_bf4(XB + (size_t)row * 1024 + i * 256 + lane * 4, v); }
        sq = wave_sum(sq);
        if (lane < 16) SS[(size_t)row * 16 + lane] = (lane == 0) ? sq : 0.f;
    } }
    }
    grid.sync();

#pragma unroll 1
    for (int layer = 0; layer < 4; ++layer) {
        WS_PTRS
        const int jl = layer >> 1;
        const bool is_attn = (layer & 1) == 0;
        const float* xin = (layer == 0) ? P.x : XR;
        conv_flat(P.p + (size_t)layer * T_ * 256, PB, (size_t)T_ * 256);
        if (is_attn) {
            { EpiQKVG epi{BIG, SS}; gemm_phase(lds, XB, 1024, WIN, 1024, 1024, T_, 4096, epi); }
            grid.sync();
            {
                float lam; const int lane = otid() & 63;
                { const float a = (lane < 64) ? P.lq1[jl * 64 + lane] * P.lk1[jl * 64 + lane] : 0.f, b2 = P.lq2[jl * 64 + lane] * P.lk2[jl * 64 + lane];
                  lam = __expf(wave_sum(a)) - __expf(wave_sum(b2)) + (layer == 0 ? P.lam_init0 : P.lam_init2); }
                const float oscale = 1.f - (layer == 0 ? P.lam_init0 : P.lam_init2);
                const int xcd = blockIdx.x & 7, slot = blockIdx.x >> 3;
                if (G == 256) {
                    for (int i = 0; i < 4; ++i) {
                        const int bh = i * 16 + xcd * 2 + (slot >> 4), pq = slot & 15;
                        const int b = bh >> 3, h = bh & 7;
                        const float slope2 = exp2f(-(float)(h + 1)) * LOG2E;
                        attn_unit(BIG, b, h, 31 - pq, lam, slope2, P.subln + jl * 128, oscale, lds);
                        attn_unit(BIG, b, h, pq, lam, slope2, P.subln + jl * 128, oscale, lds);
                    }
                } else {
                    for (int u = blockIdx.x; u < 2048; u += G) {
                        const int bh = u >> 5, qb = 31 - (u & 31); const int b = bh >> 3, h = bh & 7;
                        const float slope2 = exp2f(-(float)(h + 1)) * LOG2E;
                        attn_unit(BIG, b, h, qb, lam, slope2, P.subln + jl * 128, oscale, lds);
                    }
                }
            }
            grid.sync();
            { EpiRes epi{xin, XR, BIG + 2048, 4096}; gemm_phase(lds, BIG, 4096, WOA + (size_t)jl * 1024 * 1024, 1024, 1024, T_, 1024, epi); }
            { EpiE epi{BIG + 1024, 4096}; gemm_phase(lds, PB, 256, WP + (size_t)layer * 1024 * 256, 256, 256, T_, 1024, epi); }
            grid.sync();
            if (layer + 1 < 4) conv_T(P.sgu_w_in + (size_t)jl * 1024 * 6144, 1024, 6144, WIN, P.sgu_norm + jl * 1024, 0, 1.f, lds);
            { EpiGate epi{XR, BIG + 1024, 4096, XB, SS}; gemm_phase(lds, BIG + 2048, 4096, WG + (size_t)layer * 1024 * 1024, 1024, 1024, T_, 1024, epi); }
            grid.sync();
        } else {
            { EpiSguIn epi{BIG, SS, VST}; gemm_phase(lds, XB, 1024, WIN, 1024, 1024, T_, 6144, epi); }
            grid.sync();
            for (int u = blockIdx.x; u < 2048; u += G) {
                sgu_unit(BIG, u >> 3, u & 7, WSB + (size_t)jl * 8 * 128 * 128, P.b_s + jl * 8 * 128, P.ln_g + jl * 2048, P.ln_b + jl * 2048, VST, lds);
            }
            grid.sync();
            { EpiRes epi{xin, XR, BIG + 4096, 6144}; gemm_phase(lds, BIG, 6144, WOS + (size_t)jl * 1024 * 2048, 2048, 2048, T_, 1024, epi); }
            { EpiE epi{BIG + 2048, 6144}; gemm_phase(lds, PB, 256, WP + (size_t)layer * 1024 * 256, 256, 256, T_, 1024, epi); }
            grid.sync();
            if (layer + 1 < 4) conv_T(P.attn_w_in + (size_t)(jl + 1) * 1024 * 4096, 1024, 4096, WIN, P.attn_norm + (jl + 1) * 1024, 1024, 0.125f * LOG2E, lds);
            { EpiGate epi{XR, BIG + 2048, 6144, XB, SS}; gemm_phase(lds, BIG + 4096, 6144, WG + (size_t)layer * 1024 * 1024, 1024, 1024, T_, 1024, epi); }
            grid.sync();
        }
    }
    WS_PTRS
    const int tid = otid(), wid = tid >> 6, lane = tid & 63;
    for (int row = blockIdx.x * 8 + wid; row < T_; row += G * 8) {
        const float rs = rs_from_ss(SS, row);
        float* xr = XR + (size_t)row * 1024;
#pragma unroll
        for (int i = 0; i < 4; ++i) { const int c = i * 256 + lane * 4; const f32x4 v = *(const f32x4*)(xr + c), gg = *(const f32x4*)(P.final_norm + c);
            *(f32x4*)(xr + c) = v * rs * gg; }
    }
}

extern "C" void kernel_launch(void* const* d_in, const int* in_sizes, int n_in, void* d_out, int out_size, void* d_ws, size_t ws_size, hipStream_t stream) {
    static int grid_blocks = 0;
    if (!grid_blocks) {
        int dev = 0, cus = 0, per_cu = 0;
        hipGetDevice(&dev);
        hipDeviceGetAttribute(&cus, hipDeviceAttributeMultiprocessorCount, dev);
        hipFuncSetAttribute((const void*)mega_fwd, hipFuncAttributeMaxDynamicSharedMemorySize, LDS_BYTES);
        hipOccupancyMaxActiveBlocksPerMultiprocessor(&per_cu, mega_fwd, 512, LDS_BYTES);
        if (per_cu < 1) per_cu = 1;
        grid_blocks = cus * 1;
    }
    Params P{};
    const float** pp = (const float**)&P;
    for (int i = 0; i < 20; ++i) pp[i] = (const float*)d_in[i];
    P.out = (float*)d_out; P.ws = (char*)d_ws;
    P.lam_init0 = 0.2f; P.lam_init2 = (float)(0.8 - 0.6 * 0.54881163609402643);
    void* args[] = {&P};
    hipError_t e = hipLaunchCooperativeKernel((void*)mega_fwd, dim3(grid_blocks), dim3(512), args, LDS_BYTES, stream);
    if (e != hipSuccess) fprintf(stderr, "cooperative launch failed: %s (grid %d)\n", hipGetErrorString(e), grid_blocks);
}
```

```cpp
#include <hip/hip_runtime.h>
#include <hip/hip_cooperative_groups.h>
#include <cstdio>
#include <cstdint>
namespace cg = cooperative_groups;

#define DI __device__ __forceinline__
typedef unsigned short bf16_t;
typedef short bf16x8 __attribute__((ext_vector_type(8)));
typedef short s16x4 __attribute__((ext_vector_type(4)));
typedef float f32x2 __attribute__((ext_vector_type(2)));
typedef float f32x4 __attribute__((ext_vector_type(4)));
typedef float f32x16 __attribute__((ext_vector_type(16)));
typedef __bf16 bf16x2v __attribute__((ext_vector_type(2)));
typedef unsigned u32x2 __attribute__((ext_vector_type(2)));
typedef unsigned u32x4 __attribute__((ext_vector_type(4)));

constexpr int T_ = 32768, S_ = 4096;
constexpr size_t MiB = 1024 * 1024;
constexpr size_t OFF_XB = 0, OFF_BIG = 64 * MiB, OFF_WIN = 448 * MiB, OFF_WOA = 460 * MiB, OFF_WOS = 464 * MiB, OFF_WP = 472 * MiB,
                 OFF_WG = 474 * MiB, OFF_PB = 482 * MiB, OFF_SS = 498 * MiB, OFF_VST = 500 * MiB, OFF_WSB = 508 * MiB, OFF_BAR = 509 * MiB;
constexpr int LDS_BYTES = 128 * 1024;
#ifndef PROBE_ATTN_REPS
#define PROBE_ATTN_REPS 1
#endif
#define LOG2E 1.4426950408889634f

struct Params {
    const float *x, *p, *attn_norm, *attn_w_in, *lq1, *lk1, *lq2, *lk2, *subln, *attn_w_out, *sgu_norm, *sgu_w_in, *ln_g, *ln_b, *w_s, *b_s,
        *sgu_w_out, *ple_proj, *ple_gate, *final_norm;
    float* out;
    char* ws;
    float lam_init0, lam_init2;
};

DI int otid() { int t = threadIdx.x; asm volatile("" : "+v"(t)); return t; }
DI unsigned pk2(float a, float b) { f32x2 v = {a, b}; return __builtin_bit_cast(unsigned, __builtin_convertvector(v, bf16x2v)); }
DI bf16_t f2bf(float a) { return (bf16_t)(pk2(a, 0.f) & 0xffffu); }
DI float bflo(unsigned u) { return __uint_as_float(u << 16); }
DI float bfhi(unsigned u) { return __uint_as_float(u & 0xffff0000u); }
DI float sigmoidf_(float x) { return __builtin_amdgcn_rcpf(1.f + __builtin_amdgcn_exp2f(-x * LOG2E)); }
DI float siluf_(float x) { return x * sigmoidf_(x); }
DI f32x2 gelu_pk(f32x2 v) {
    const f32x2 av = __builtin_elementwise_abs(v), d = av * 0.2316418882f + 1.0f;
    f32x2 t; t.x = __builtin_amdgcn_rcpf(d.x); t.y = __builtin_amdgcn_rcpf(d.y);
    f32x2 q = t * 0.5307027145f + (-0.7265760135f); q = q * t + 0.7107068705f; q = q * t + (-0.142248368f); q = q * t + 0.127414796f; q = q * t;
    const f32x2 s = (v * v) * (-0.72134752044f);
    f32x2 e; e.x = __builtin_amdgcn_exp2f(s.x); e.y = __builtin_amdgcn_exp2f(s.y);
    const f32x2 m = v * (q * e), r = v - m;
    f32x2 o; o.x = v.x < 0.f ? m.x : r.x; o.y = v.y < 0.f ? m.y : r.y; return o;
}
DI int fxr(int row) { return ((row & 3) << 2) | ((row >> 2) & 3); }

DI void conv_T(const float* src, int K, int N, bf16_t* dst, const float* gain, int nscale, float cs, char* ldsc) {
    float* lds = (float*)ldsc;
    const int tilesN = N / 64, ntile = (K / 64) * tilesN;
    for (int ti = blockIdx.x; ti < ntile; ti += gridDim.x) {
        const int tk = ti / tilesN, tn = ti % tilesN; const int tx = otid();
        __syncthreads();
#pragma unroll
        for (int i = 0; i < 8; ++i) {
            const int e = tx + i * 512, kk = e >> 6, nn = e & 63;
            float v = src[(size_t)(tk * 64 + kk) * N + tn * 64 + nn];
            if (gain) v *= gain[tk * 64 + kk];
            if (tn * 64 + nn < nscale) v *= cs;
            lds[kk * 65 + nn] = v;
        }
        __syncthreads();
#pragma unroll
        for (int i = 0; i < 8; ++i) {
            const int e = tx + i * 512, nn = e >> 6, kk = e & 63;
            dst[(size_t)(tn * 64 + nn) * K + tk * 64 + kk] = f2bf(lds[kk * 65 + nn]);
        }
    }
}
DI void conv_flat(const float* src, bf16_t* dst, size_t n) {
    const size_t nch = n / 8;
    const int tx = otid();
    for (size_t c = (size_t)blockIdx.x * 512 + tx; c < nch; c += (size_t)gridDim.x * 512) {
        const f32x4 a = *(const f32x4*)(src + c * 8), b = *(const f32x4*)(src + c * 8 + 4);
        u32x4 w; w.x = pk2(a[0], a[1]); w.y = pk2(a[2], a[3]); w.z = pk2(b[0], b[1]); w.w = pk2(b[2], b[3]);
        *(u32x4*)(dst + c * 8) = w;
    }
}

typedef __attribute__((address_space(3))) unsigned char lds_uc;
constexpr int HTB = 128 * 64 * 2;
DI int lds_byte(int r, int c) { const int st = (r >> 4) * 2 + (c >> 5), rr = r & 15, cc = c & 31, ob = rr * 64 + cc * 2; return st * 1024 + (ob ^ (((ob >> 9) & 1) << 5)); }
DI void stage_rc(int b, int& R, int& C) { const int st = b / 1024, sb = b % 1024, swz = sb ^ (((sb >> 9) & 1) << 5); R = (st >> 1) * 16 + swz / 64; C = (st & 1) * 32 + (swz % 64) / 2; }
struct Unit { int pm, pn; };
struct StaticOrder {
    int nM, nN, nwg, G, c;
    DI void init(int M, int N, int G_, int c_) { nM = M / 256; nN = N / 256; nwg = nM * nN; G = G_; c = c_; }
    DI bool next(int i, Unit& u) const {
        const long L = (long)i * G + c; if (L >= nwg) return false;
        int wgid = (int)L; { const int q = nwg / 8, r = nwg % 8, xcd = wgid % 8, off = wgid / 8; wgid = (xcd < r ? xcd * (q + 1) : r * (q + 1) + (xcd - r) * q) + off; }
        const int nig = 8 * nN, gid = wgid / nig, fm = gid * 8, gsz = (nM - fm) < 8 ? (nM - fm) : 8;
        u.pm = fm + ((wgid % nig) % gsz); u.pn = (wgid % nig) / gsz; return true;
    }
};

template <class Epi>
DI void gemm_phase(char* lds_generic, const bf16_t* A, int lda, const bf16_t* Bt, int ldb, int K, int M, int N, const Epi& E) {
    lds_uc* lds = (lds_uc*)lds_generic;
    const int tid = otid(), wid = __builtin_amdgcn_readfirstlane(tid >> 6), lane = tid & 63, wr = wid >> 2, wc = wid & 3, fr = lane & 15, fq = lane >> 4;
    StaticOrder S; S.init(M, N, gridDim.x, blockIdx.x);
    const int nt = K / 64;
    unsigned voffA[2], voffB[2];
#pragma unroll
    for (int i = 0; i < 2; ++i) { int R, C; stage_rc(tid * 16 + i * 8192, R, C); voffA[i] = (unsigned)(R * lda + C) * 2u; voffB[i] = (unsigned)(R * ldb + C) * 2u; }
    const size_t kstep = 128;
    const size_t hstepA = (size_t)128 * lda * 2, hstepB = (size_t)128 * ldb * 2, tstepA = 2 * hstepA, tstepB = 2 * hstepB;
    const unsigned ldsw = (unsigned)wid * 1024u;
    const int aoff = lds_byte(wr * 64 + fr, fq * 8), boff = lds_byte(wc * 32 + fr, fq * 8);
#define PG8_SA(b, h) (((b) * 2 + (h)) * HTB)
#define PG8_SB(b, h) ((4 + (b) * 2 + (h)) * HTB)
#define PG8_STAGE(bufoff, gbase, voff) do { _Pragma("unroll") for (int _i = 0; _i < 2; ++_i) \
        __builtin_amdgcn_global_load_lds((const unsigned*)((const char*)(gbase) + (voff)[_i]), (__attribute__((address_space(3))) unsigned*)(lds + (bufoff) + ldsw + _i * 8192), 16, 0, 0); } while (0)
#define PG8_LDA(dst, b, h) do { _Pragma("unroll") for (int m = 0; m < 4; ++m) _Pragma("unroll") for (int k = 0; k < 2; ++k) dst[m][k] = *(const __attribute__((address_space(3))) bf16x8*)(lds + PG8_SA(b, h) + aoff + m * 2048 + k * 1024); } while (0)
#define PG8_LDB(dst, b, h) do { _Pragma("unroll") for (int n = 0; n < 2; ++n) _Pragma("unroll") for (int k = 0; k < 2; ++k) dst[n][k] = *(const __attribute__((address_space(3))) bf16x8*)(lds + PG8_SB(b, h) + boff + n * 2048 + k * 1024); } while (0)
#define PG8_MMA(ai, bj, At, Bt_) do { __builtin_amdgcn_s_setprio(1); _Pragma("unroll") for (int m = 0; m < 4; ++m) _Pragma("unroll") for (int n = 0; n < 2; ++n) _Pragma("unroll") for (int k = 0; k < 2; ++k) \
        acc[ai][bj][m][n] = __builtin_amdgcn_mfma_f32_16x16x32_bf16(Bt_[n][k], At[m][k], acc[ai][bj][m][n], 0, 0, 0); __builtin_amdgcn_s_setprio(0); } while (0)
#define PG8_WAIT_V(n) asm volatile("s_waitcnt vmcnt(" #n ")" ::: "memory")
#define PG8_WAIT_L(n) asm volatile("s_waitcnt lgkmcnt(" #n ")" ::: "memory")
#define PG8_BAR __builtin_amdgcn_s_barrier()
#define PG8_SCHED __builtin_amdgcn_sched_barrier(0)
    Unit cur, nxt; int ui = 0;
    __syncthreads();
    if (!S.next(0, cur)) return;
    PG8_WAIT_V(0);
    f32x4 acc[2][2][4][2];
#pragma unroll
    for (int a = 0; a < 2; ++a)
#pragma unroll
        for (int b = 0; b < 2; ++b)
#pragma unroll
            for (int m = 0; m < 4; ++m)
#pragma unroll
                for (int n = 0; n < 2; ++n) acc[a][b][m][n] = (f32x4){0.f, 0.f, 0.f, 0.f};
    bf16x8 At[4][2], B0[2][2], B1[2][2];
    const char* cA = (const char*)A + (size_t)cur.pm * tstepA; const char* cB = (const char*)Bt + (size_t)cur.pn * tstepB;
    PG8_STAGE(PG8_SB(0, 0), cB, voffB); PG8_STAGE(PG8_SA(0, 0), cA, voffA); PG8_STAGE(PG8_SB(0, 1), cB + hstepB, voffB); PG8_STAGE(PG8_SA(0, 1), cA + hstepA, voffA);
    if (wr == 1) PG8_BAR;
    PG8_WAIT_V(4); PG8_BAR;
    PG8_STAGE(PG8_SB(1, 0), cB + kstep, voffB); PG8_STAGE(PG8_SA(1, 0), cA + kstep, voffA); PG8_STAGE(PG8_SB(1, 1), cB + hstepB + kstep, voffB);
    PG8_WAIT_V(6); PG8_BAR;
    for (;;) {
        const bool has_next = S.next(ui + 1, nxt);
        const char* nA = has_next ? (const char*)A + (size_t)nxt.pm * tstepA : cA; const char* nB = has_next ? (const char*)Bt + (size_t)nxt.pn * tstepB : cB;
#pragma unroll 1
        for (int t = 0; t < nt; t += 2) {
            const bool last = (t == nt - 2);
            const char* a1 = cA + (size_t)(t + 1) * kstep;
            const char* a2 = last ? nA : cA + (size_t)(t + 2) * kstep; const char* b2 = last ? nB : cB + (size_t)(t + 2) * kstep;
            const char* a3 = a2 + kstep; const char* b3 = b2 + kstep;
            PG8_LDB(B0, 0, 0); PG8_SCHED; PG8_LDA(At, 0, 0); PG8_STAGE(PG8_SA(1, 1), a1 + hstepA, voffA);
            PG8_WAIT_L(8); PG8_BAR; PG8_WAIT_L(0); PG8_MMA(0, 0, At, B0); PG8_BAR; PG8_SCHED;
            PG8_LDB(B1, 0, 1); PG8_STAGE(PG8_SB(0, 0), b2, voffB);
            PG8_BAR; PG8_WAIT_L(0); PG8_MMA(0, 1, At, B1); PG8_BAR;
            PG8_LDA(At, 0, 1); PG8_STAGE(PG8_SA(0, 0), a2, voffA);
            PG8_BAR; PG8_WAIT_L(0); PG8_MMA(1, 0, At, B0); PG8_BAR; PG8_SCHED;
            PG8_STAGE(PG8_SB(0, 1), b2 + hstepB, voffB);
            PG8_WAIT_V(6); PG8_BAR; PG8_MMA(1, 1, At, B1); PG8_BAR;
            PG8_LDB(B0, 1, 0); PG8_SCHED; PG8_LDA(At, 1, 0); PG8_STAGE(PG8_SA(0, 1), a2 + hstepA, voffA);
            PG8_WAIT_L(8); PG8_BAR; PG8_WAIT_L(0); PG8_MMA(0, 0, At, B0); PG8_BAR; PG8_SCHED;
            PG8_LDB(B1, 1, 1); PG8_STAGE(PG8_SB(1, 0), b3, voffB);
            PG8_BAR; PG8_WAIT_L(0); PG8_MMA(0, 1, At, B1); PG8_BAR;
            PG8_LDA(At, 1, 1); PG8_STAGE(PG8_SA(1, 0), a3, voffA);
            PG8_BAR; PG8_WAIT_L(0); PG8_MMA(1, 0, At, B0); PG8_BAR; PG8_SCHED;
            PG8_STAGE(PG8_SB(1, 1), b3 + hstepB, voffB);
            PG8_WAIT_V(6); PG8_BAR; PG8_MMA(1, 1, At, B1); PG8_BAR;
        }
        E(acc, cur.pm, cur.pn, wr, wc, fr, fq);
        if (!has_next) break;
#pragma unroll
        for (int a = 0; a < 2; ++a)
#pragma unroll
            for (int b = 0; b < 2; ++b)
#pragma unroll
                for (int m = 0; m < 4; ++m)
#pragma unroll
                    for (int n = 0; n < 2; ++n) acc[a][b][m][n] = (f32x4){0.f, 0.f, 0.f, 0.f};
        cur = nxt; cA = nA; cB = nB; ++ui;
    }
    PG8_WAIT_V(0);
    if (wr == 0) PG8_BAR;
    PG8_BAR;
}

#define EPI_ARGS const f32x4 (&acc)[2][2][4][2], int pm, int pn, int wr, int wc, int fr, int fq
#define ROW_OF(ai, m) (pm * 256 + (ai) * 128 + wr * 64 + (m) * 16 + fr)
#define COL_OF(bj, n) (pn * 256 + (bj) * 128 + wc * 32 + (n) * 16 + fq * 4)
DI float rs_from_ss(const float* ss, int row) {
    const f32x4* p = (const f32x4*)(ss + (size_t)row * 16); const f32x4 s = (p[0] + p[1]) + (p[2] + p[3]);
    return rsqrtf(((s[0] + s[1]) + (s[2] + s[3])) * (1.f / 1024.f) + 1e-6f); }
DI void st_bf4(bf16_t* p, f32x4 v) { u32x2 w; w.x = pk2(v[0], v[1]); w.y = pk2(v[2], v[3]); *(u32x2*)p = w; }
DI float quad_sum(float v) { v += __shfl_xor(v, 16); v += __shfl_xor(v, 32); return v; }

struct EpiQKVG {
    bf16_t* out; const float* ss;
    DI void operator()(EPI_ARGS) const {
#pragma unroll
        for (int ai = 0; ai < 2; ++ai)
#pragma unroll
            for (int m = 0; m < 4; ++m) { const int row = ROW_OF(ai, m); const float rs = rs_from_ss(ss, row);
#pragma unroll
                for (int bj = 0; bj < 2; ++bj)
#pragma unroll
                    for (int n = 0; n < 2; ++n) st_bf4(out + (size_t)row * 4096 + COL_OF(bj, n), acc[ai][bj][m][n] * rs); }
    }
};
struct EpiSguIn {
    bf16_t* z; const float* ss; float* vst;
    DI void operator()(EPI_ARGS) const {
        const bool do_gelu = pn < 16, do_stats = (pn >= 8) && (pn < 16);
#pragma unroll
        for (int ai = 0; ai < 2; ++ai)
#pragma unroll
            for (int m = 0; m < 4; ++m) { const int row = ROW_OF(ai, m); const float rs = rs_from_ss(ss, row); float s1 = 0.f, s2 = 0.f;
#pragma unroll
                for (int bj = 0; bj < 2; ++bj)
#pragma unroll
                    for (int n = 0; n < 2; ++n) { f32x4 v = acc[ai][bj][m][n] * rs;
                        if (do_gelu) { const f32x2 a = gelu_pk((f32x2){v[0], v[1]}), b = gelu_pk((f32x2){v[2], v[3]}); v = (f32x4){a.x, a.y, b.x, b.y}; }
                        s1 += (v[0] + v[1]) + (v[2] + v[3]); s2 += (v[0] * v[0] + v[1] * v[1]) + (v[2] * v[2] + v[3] * v[3]);
                        st_bf4(z + (size_t)row * 6144 + COL_OF(bj, n), v); }
                if (do_stats) { s1 = quad_sum(s1); s2 = quad_sum(s2);
                    if (fq == 0) *(f32x2*)(vst + ((size_t)row * 32 + (pn - 8) * 4 + wc) * 2) = (f32x2){s1, s2}; } }
    }
};
struct EpiRes {
    const float* xin; float* xr; bf16_t* xb; int ldxb;
    DI void operator()(EPI_ARGS) const {
#pragma unroll
        for (int ai = 0; ai < 2; ++ai)
#pragma unroll
            for (int m = 0; m < 4; ++m) { const int row = ROW_OF(ai, m);
#pragma unroll
                for (int bj = 0; bj < 2; ++bj)
#pragma unroll
                    for (int n = 0; n < 2; ++n) { const int col = COL_OF(bj, n); const f32x4 v = *(const f32x4*)(xin + (size_t)row * 1024 + col) + acc[ai][bj][m][n];
                        *(f32x4*)(xr + (size_t)row * 1024 + col) = v; st_bf4(xb + (size_t)row * ldxb + col, v); } }
    }
};
struct EpiE {
    bf16_t* e; int lde;
    DI void operator()(EPI_ARGS) const {
#pragma unroll
        for (int ai = 0; ai < 2; ++ai)
#pragma unroll
            for (int m = 0; m < 4; ++m) { const int row = ROW_OF(ai, m);
#pragma unroll
                for (int bj = 0; bj < 2; ++bj)
#pragma unroll
                    for (int n = 0; n < 2; ++n) st_bf4(e + (size_t)row * lde + COL_OF(bj, n), acc[ai][bj][m][n]); }
    }
};
struct EpiGate {
    float* xr; const bf16_t* e; int lde; bf16_t* xb; float* ss;
    DI void operator()(EPI_ARGS) const {
#pragma unroll
        for (int ai = 0; ai < 2; ++ai)
#pragma unroll
            for (int m = 0; m < 4; ++m) { const int row = ROW_OF(ai, m); float s2 = 0.f;
#pragma unroll
                for (int bj = 0; bj < 2; ++bj)
#pragma unroll
                    for (int n = 0; n < 2; ++n) { const int col = COL_OF(bj, n);
                        const f32x4 xm = *(const f32x4*)(xr + (size_t)row * 1024 + col); const u32x2 ew = *(const u32x2*)(e + (size_t)row * lde + col);
                        const f32x4 g = acc[ai][bj][m][n]; f32x4 v;
                        v[0] = xm[0] + bflo(ew.x) * sigmoidf_(g[0]); v[1] = xm[1] + bfhi(ew.x) * sigmoidf_(g[1]);
                        v[2] = xm[2] + bflo(ew.y) * sigmoidf_(g[2]); v[3] = xm[3] + bfhi(ew.y) * sigmoidf_(g[3]);
                        s2 += (v[0] * v[0] + v[1] * v[1]) + (v[2] * v[2] + v[3] * v[3]);
                        *(f32x4*)(xr + (size_t)row * 1024 + col) = v; st_bf4(xb + (size_t)row * 1024 + col, v); }
                s2 = quad_sum(s2);
                if (fq == 0) ss[(size_t)row * 16 + pn * 4 + wc] = s2; }
    }
};

DI void attn_unit(bf16_t* big, bf16_t* osp, int b, int h, int qb, float lam, float slope2, const float* subln_g, float oscale, char* lds) {
    int tid_ = threadIdx.x; asm volatile("" : "+v"(tid_));
    const int tid = tid_, wid = tid >> 6, lane = tid & 63, w = wid & 3, j = wid >> 2, hf = lane >> 5, l32 = lane & 31;
    const int q0 = qb * 128;
    const size_t rowbase = (size_t)b * S_;
    const float NEG_INF = -__builtin_inff();
    bf16x8 qf[4];
    { const bf16_t* Qp = big + (rowbase + q0 + 32 * w + l32) * 4096 + h * 128 + j * 64;
#pragma unroll
      for (int ks = 0; ks < 4; ++ks) qf[ks] = *(const bf16x8*)(Qp + 16 * ks + 8 * hf); }
    f32x16 o[4];
#pragma unroll
    for (int mo = 0; mo < 4; ++mo)
#pragma unroll
        for (int r = 0; r < 16; ++r) o[mo][r] = 0.f;
    float m_run = NEG_INF, l_run = 0.f;
    const int nkt = 2 * qb + 2;
    const bf16_t* Kg = big + rowbase * 4096 + 1024 + h * 128;
    const bf16_t* Vg = big + rowbase * 4096 + 2048 + h * 128;
    u32x4 rg[4];
    auto load_tile = [&](int kt) {
        const size_t key = (size_t)kt * 64 + (tid >> 3);
        rg[0] = *(const u32x4*)(Kg + key * 4096 + (tid & 7) * 8);
        rg[1] = *(const u32x4*)(Kg + key * 4096 + 64 + (tid & 7) * 8);
#pragma unroll
        for (int i = 0; i < 2; ++i) { const int c = tid + 512 * i; const size_t k2 = (size_t)kt * 64 + (c >> 4); rg[2 + i] = *(const u32x4*)(Vg + k2 * 4096 + (c & 15) * 8); }
    };
    auto store_tile = [&](char* buf) {
        { const int row = tid >> 3, ch = tid & 7; const int o_ = row * 128 + ((ch ^ (row & 7)) << 4);
          *(u32x4*)(buf + o_) = rg[0]; *(u32x4*)(buf + 8192 + o_) = rg[1]; }
#pragma unroll
        for (int i = 0; i < 2; ++i) { const int c = tid + 512 * i, row = c >> 4, ch = c & 15; *(u32x4*)(buf + 16384 + row * 256 + ((ch ^ fxr(row)) << 4)) = rg[2 + i]; }
    };
    __syncthreads();
    load_tile(nkt - 1);
    store_tile(lds);
    __syncthreads();
    const int g_blk = (lane >> 4) & 1, g_q = (lane & 15) >> 2, g_p = lane & 3;
    int it = 0;
    for (int kt = nkt - 1; kt >= 0; --kt, ++it) {
        char* buf = lds + (it & 1) * 32768;
        char* nbuf = lds + ((it + 1) & 1) * 32768;
        if (kt > 0) load_tile(kt - 1);
        const bool skip = (64 * kt > q0 + 32 * w + 31);
        if (!skip) {
            const char* kb = buf + j * 8192; const char* vb = buf + 16384;
            f32x16 st[2];
#pragma unroll
            for (int mt = 0; mt < 2; ++mt) {
#pragma unroll
                for (int r = 0; r < 16; ++r) st[mt][r] = 0.f;
#pragma unroll
                for (int ks = 0; ks < 4; ++ks) { const int row = 32 * mt + l32, ch = 2 * ks + hf;
                    const bf16x8 kf = *(const bf16x8*)(kb + row * 128 + ((ch ^ (row & 7)) << 4));
                    st[mt] = __builtin_amdgcn_mfma_f32_32x32x16_bf16(kf, qf[ks], st[mt], 0, 0, 0); }
            }
            __builtin_amdgcn_sched_barrier(0);
            const float kbias = slope2 * (float)(64 * kt - q0 + 4 * hf);
            const bool diag = (64 * kt + 63 > q0 + 32 * w);
            const int qrel = q0 + 32 * w + l32 - 64 * kt - 4 * hf;
            float tm = NEG_INF;
#pragma unroll
            for (int mt = 0; mt < 2; ++mt)
#pragma unroll
                for (int r = 0; r < 16; ++r) { const int ko = 32 * mt + (r & 3) + 8 * (r >> 2);
                    float s = st[mt][r] + (kbias + slope2 * (float)ko);
                    if (diag && ko > qrel) s = NEG_INF;
                    st[mt][r] = s; tm = fmaxf(tm, s); }
            tm = fmaxf(tm, __shfl_xor(tm, 32));
            const float mn = fmaxf(m_run, tm);
            const float alpha = __builtin_amdgcn_exp2f(m_run - mn);
            m_run = mn;
            float ps = 0.f;
#pragma unroll
            for (int mt = 0; mt < 2; ++mt)
#pragma unroll
                for (int r = 0; r < 16; ++r) { const float p = __builtin_amdgcn_exp2f(st[mt][r] - mn); st[mt][r] = p; ps += p; }
            l_run = l_run * alpha + ps;
            if (__any(alpha != 1.f)) {
#pragma unroll
                for (int mo = 0; mo < 4; ++mo)
#pragma unroll
                    for (int r = 0; r < 16; ++r) o[mo][r] *= alpha;
            }
            __builtin_amdgcn_sched_barrier(0);
            bf16x8 pf[4];
#pragma unroll
            for (int kk = 0; kk < 4; ++kk) { const int mt = kk >> 1, s8 = (kk & 1) * 8; u32x4 pw;
                pw.x = pk2(st[mt][s8 + 0], st[mt][s8 + 1]); pw.y = pk2(st[mt][s8 + 2], st[mt][s8 + 3]);
                pw.z = pk2(st[mt][s8 + 4], st[mt][s8 + 5]); pw.w = pk2(st[mt][s8 + 6], st[mt][s8 + 7]);
                pf[kk] = __builtin_bit_cast(bf16x8, pw); }
            __builtin_amdgcn_sched_barrier(0);
#pragma unroll
            for (int mo = 0; mo < 4; ++mo)
#pragma unroll
                for (int kk = 0; kk < 4; ++kk) {
                    const int row0 = 16 * kk + 4 * hf + g_q, row1 = row0 + 8, ch = 4 * mo + 2 * g_blk + (g_p >> 1);
                    const s16x4 lo = __builtin_amdgcn_ds_read_tr16_b64_v4i16((__attribute__((address_space(3))) s16x4*)(vb + row0 * 256 + ((ch ^ fxr(row0)) << 4) + 8 * (g_p & 1)));
                    const s16x4 hi = __builtin_amdgcn_ds_read_tr16_b64_v4i16((__attribute__((address_space(3))) s16x4*)(vb + row1 * 256 + ((ch ^ fxr(row1)) << 4) + 8 * (g_p & 1)));
                    const bf16x8 vf = {lo[0], lo[1], lo[2], lo[3], hi[0], hi[1], hi[2], hi[3]};
                    o[mo] = __builtin_amdgcn_mfma_f32_32x32x16_bf16(vf, pf[kk], o[mo], 0, 0, 0);
                    if (kk == 3) __builtin_amdgcn_sched_barrier(0);
                }
        }
        if (kt > 0) store_tile(nbuf);
        __syncthreads();
    }
    const float l_tot = l_run + __shfl_xor(l_run, 32);
    float inv = 1.f / l_tot; if (j == 1) inv *= lam;
    float* ex = (float*)lds;
    if (j == 1) {
#pragma unroll
        for (int mo = 0; mo < 4; ++mo)
#pragma unroll
            for (int r = 0; r < 16; ++r) ex[(w * 64 + mo * 16 + r) * 64 + lane] = o[mo][r] * inv;
    }
    __syncthreads();
    if (j == 0) {
        float sq = 0.f;
#pragma unroll
        for (int mo = 0; mo < 4; ++mo)
#pragma unroll
            for (int r = 0; r < 16; ++r) { const float v = o[mo][r] * inv - ex[(w * 64 + mo * 16 + r) * 64 + lane]; o[mo][r] = v; sq += v * v; }
        sq += __shfl_xor(sq, 32);
        const float rn = rsqrtf(sq * (1.f / 128.f) + 1e-5f) * oscale;
        const bf16_t* rowp = big + (rowbase + q0 + 32 * w + l32) * 4096 + h * 128;
        bf16_t* orow = osp + (rowbase + q0 + 32 * w + l32) * 1024 + h * 128;
#pragma unroll
        for (int mo = 0; mo < 4; ++mo)
#pragma unroll
            for (int rq = 0; rq < 4; ++rq) { const int dv = 32 * mo + 8 * rq + 4 * hf;
                const u32x2 gw = *(const u32x2*)(rowp + 3072 + dv); const f32x4 sg = *(const f32x4*)(subln_g + dv);
                f32x4 v;
                v[0] = o[mo][4 * rq + 0] * rn * sg[0] * siluf_(bflo(gw.x)); v[1] = o[mo][4 * rq + 1] * rn * sg[1] * siluf_(bfhi(gw.x));
                v[2] = o[mo][4 * rq + 2] * rn * sg[2] * siluf_(bflo(gw.y)); v[3] = o[mo][4 * rq + 3] * rn * sg[3] * siluf_(bfhi(gw.y));
                st_bf4(orow + dv, v); }
    }
}

DI void sgu_unit(bf16_t* z, int chunk, int g, const bf16_t* wsb, const float* bs, const float* lng, const float* lnb, const float* vst, char* lds) {
    int tid_ = threadIdx.x; asm volatile("" : "+v"(tid_));
    const int tid = tid_, wid = tid >> 6, lane = tid & 63, tt = wid & 3, dh = wid >> 2, hf = lane >> 5, l32 = lane & 31;
    const int t0 = chunk * 128;
    float* stt = (float*)(lds + 65536);
    __syncthreads();
    if (tid < 128) { const f32x4* pv = (const f32x4*)(vst + (size_t)(t0 + tid) * 64); float s1 = 0.f, s2 = 0.f;
#pragma unroll
        for (int i = 0; i < 16; ++i) { const f32x4 q4 = pv[i]; s1 += q4[0] + q4[2]; s2 += q4[1] + q4[3]; }
        const float mu = s1 * (1.f / 2048.f), var = s2 * (1.f / 2048.f) - mu * mu;
        stt[2 * tid] = mu; stt[2 * tid + 1] = rsqrtf(fmaxf(var, 0.f) + 1e-5f); }
    const int nks = 2 * (tt + 1);
    bf16x8 wf[8];
#pragma unroll
    for (int ks = 0; ks < 8; ++ks) { if (ks < nks) wf[ks] = *(const bf16x8*)(wsb + ((size_t)g * 128 + 32 * tt + l32) * 128 + 16 * ks + 8 * hf); else wf[ks] = (bf16x8){0, 0, 0, 0, 0, 0, 0, 0}; }
    const int ch = tid & 31;
    float gq[8], bq[8];
    { const f32x4 a = *(const f32x4*)(lng + g * 256 + ch * 8), b = *(const f32x4*)(lng + g * 256 + ch * 8 + 4), c = *(const f32x4*)(lnb + g * 256 + ch * 8), d = *(const f32x4*)(lnb + g * 256 + ch * 8 + 4);
#pragma unroll
      for (int i = 0; i < 4; ++i) { gq[i] = a[i]; gq[4 + i] = b[i]; bq[i] = c[i]; bq[4 + i] = d[i]; } }
    __syncthreads();
#pragma unroll
    for (int i = 0; i < 8; ++i) { const int row = (tid >> 5) + 16 * i;
        const u32x4 raw = *(const u32x4*)(z + (size_t)(t0 + row) * 6144 + 2048 + g * 256 + ch * 8);
        const float mu = stt[2 * row], rstd = stt[2 * row + 1];
        float f[8]; f[0] = bflo(raw.x); f[1] = bfhi(raw.x); f[2] = bflo(raw.y); f[3] = bfhi(raw.y); f[4] = bflo(raw.z); f[5] = bfhi(raw.z); f[6] = bflo(raw.w); f[7] = bfhi(raw.w);
#pragma unroll
        for (int e = 0; e < 8; ++e) f[e] = (f[e] - mu) * rstd * gq[e] + bq[e];
        u32x4 w4; w4.x = pk2(f[0], f[1]); w4.y = pk2(f[2], f[3]); w4.z = pk2(f[4], f[5]); w4.w = pk2(f[6], f[7]);
        *(u32x4*)(lds + row * 512 + ((ch ^ fxr(row)) << 4)) = w4; }
    __syncthreads();
    f32x16 acc[4];
#pragma unroll
    for (int mo = 0; mo < 4; ++mo)
#pragma unroll
        for (int r = 0; r < 16; ++r) acc[mo][r] = 0.f;
    const int g_blk = (lane >> 4) & 1, g_q = (lane & 15) >> 2, g_p = lane & 3;
#pragma unroll
    for (int ks = 0; ks < 8; ++ks) {
        if (ks < nks) {
#pragma unroll
            for (int mo = 0; mo < 4; ++mo) {
                const int row0 = 16 * ks + 8 * hf + g_q, row1 = row0 + 4, chx = 4 * (dh * 4 + mo) + 2 * g_blk + (g_p >> 1);
                const s16x4 lo = __builtin_amdgcn_ds_read_tr16_b64_v4i16((__attribute__((address_space(3))) s16x4*)(lds + row0 * 512 + ((chx ^ fxr(row0)) << 4) + 8 * (g_p & 1)));
                const s16x4 hi = __builtin_amdgcn_ds_read_tr16_b64_v4i16((__attribute__((address_space(3))) s16x4*)(lds + row1 * 512 + ((chx ^ fxr(row1)) << 4) + 8 * (g_p & 1)));
                const bf16x8 vf = {lo[0], lo[1], lo[2], lo[3], hi[0], hi[1], hi[2], hi[3]};
                acc[mo] = __builtin_amdgcn_mfma_f32_32x32x16_bf16(vf, wf[ks], acc[mo], 0, 0, 0);
            }
        }
    }
    const float bsv = bs[g * 128 + 32 * tt + l32];
    bf16_t* rowp = z + (size_t)(t0 + 32 * tt + l32) * 6144 + g * 256;
#pragma unroll
    for (int mo = 0; mo < 4; ++mo)
#pragma unroll
        for (int rq = 0; rq < 4; ++rq) { const int d = (dh * 4 + mo) * 32 + 8 * rq + 4 * hf;
            const u32x2 uw = *(const u32x2*)(rowp + d), gw = *(const u32x2*)(rowp + 4096 + d);
            f32x4 v;
            v[0] = bflo(uw.x) * (acc[mo][4 * rq + 0] + bsv) * siluf_(bflo(gw.x)); v[1] = bfhi(uw.x) * (acc[mo][4 * rq + 1] + bsv) * siluf_(bfhi(gw.x));
            v[2] = bflo(uw.y) * (acc[mo][4 * rq + 2] + bsv) * siluf_(bflo(gw.y)); v[3] = bfhi(uw.y) * (acc[mo][4 * rq + 3] + bsv) * siluf_(bfhi(gw.y));
            st_bf4(rowp + d, v); }
}

DI float wave_sum(float v) {
#pragma unroll
    for (int o = 32; o > 0; o >>= 1) v += __shfl_xor(v, o);
    return v;
}

#define XB_TMO      128
#define XB_XCNT(j)  (256  + 64 * (j))
#define XB_XSUB(j)  (1280 + 64 * (j))
#define XB_XGEN(j)  (2304 + 64 * (j))
#define XB_TOP      3328
#define XB_TOPGEN   3392
#define XCD_BAR_WORDS 3456
#define XB_SPIN_CAP (1u << 18)
#define LAS __attribute__((address_space(3)))
DI unsigned xb_ld(unsigned* p)              { return __hip_atomic_load(p, __ATOMIC_RELAXED, __HIP_MEMORY_SCOPE_AGENT); }
DI unsigned xb_add(unsigned* p, unsigned v) { return __hip_atomic_fetch_add(p, v, __ATOMIC_RELAXED, __HIP_MEMORY_SCOPE_AGENT); }
DI unsigned xb_xcc_id() { return (unsigned)__builtin_amdgcn_s_getreg((3 << 11) | 20) & 0xFu; }
#define XB_SPIN(cond, bar) do { unsigned _sp = 0; while (cond) { __builtin_amdgcn_s_sleep(1); \
    if ((++_sp & 255u) == 0u) { if (xb_ld(&(bar)[XB_TMO])) break; if (_sp > XB_SPIN_CAP) { atomicAdd(&(bar)[XB_TMO], 1u); break; } } } } while (0)
struct XcdBarrier { unsigned* bar; unsigned x; volatile LAS unsigned* st; };
DI XcdBarrier xcd_barrier_post(unsigned* bar, volatile LAS unsigned* st) {
    XcdBarrier b; b.bar = bar; b.x = xb_xcc_id(); b.st = st;
    if (threadIdx.x == 0) (void)xb_add(&bar[XB_XCNT(b.x)], 1u);
    return b;
}
DI void xcd_barrier_complete(unsigned* bar, unsigned x, unsigned& nloc, unsigned& nx) {
    const unsigned G = gridDim.x * gridDim.y * gridDim.z;
    unsigned sum, cnt, mine, sp = 0u;
    for (;;) {
        sum = 0u; cnt = 0u; mine = 0u;
#pragma unroll
        for (unsigned j = 0; j < 16; ++j) { const unsigned c = xb_ld(&bar[XB_XCNT(j)]); sum += c; cnt += (c > 0u) ? 1u : 0u; mine = (j == x) ? c : mine; }
        if (sum == G) break;
        __builtin_amdgcn_s_sleep(1);
        if ((++sp & 255u) == 0u) { if (xb_ld(&bar[XB_TMO])) break; if (sp > XB_SPIN_CAP) { atomicAdd(&bar[XB_TMO], 1u); break; } }
    }
    nloc = mine > 0u ? mine : 1u; nx = cnt > 0u ? cnt : 1u;
}
DI void xcd_barrier(const XcdBarrier& b) {
    asm volatile("s_waitcnt vmcnt(0)" ::: "memory");
    __syncthreads();
    if (threadIdx.x == 0) {
        unsigned* bar = b.bar;
        __builtin_amdgcn_s_waitcnt(0);
        unsigned nloc = b.st[0], nx = b.st[1];
        if (nloc == 0u) { xcd_barrier_complete(bar, b.x, nloc, nx); b.st[0] = nloc; b.st[1] = nx; }
        const unsigned old = xb_add(&bar[XB_XSUB(b.x)], 1u);
        const unsigned gen = old / nloc;
        if (old + 1u == (gen + 1u) * nloc) {
            __builtin_amdgcn_fence(__ATOMIC_RELEASE, "agent");
            asm volatile("s_waitcnt vmcnt(0)" ::: "memory");
            const unsigned og = xb_add(&bar[XB_TOP], 1u);
            const unsigned tg = og / nx;
            if (og + 1u == (tg + 1u) * nx) xb_add(&bar[XB_TOPGEN], 1u);
            else XB_SPIN(xb_ld(&bar[XB_TOPGEN]) == tg, bar);
            __builtin_amdgcn_fence(__ATOMIC_ACQUIRE, "agent");
            xb_add(&bar[XB_XGEN(b.x)], 1u);
            asm volatile("s_waitcnt vmcnt(0)" ::: "memory");
        } else {
            XB_SPIN(xb_ld(&bar[XB_XGEN(b.x)]) == gen, bar);
            __builtin_amdgcn_fence(__ATOMIC_ACQUIRE, "agent");
            asm volatile("s_waitcnt vmcnt(0)" ::: "memory");
        }
    }
    __syncthreads();
}

typedef const __attribute__((address_space(4))) Params* kparams_t;
#define KP kparams_t pp = (kparams_t)__builtin_amdgcn_kernarg_segment_ptr(); asm volatile("" : "+s"(pp)); char* ws = pp->ws; (void)ws;
#define W_XB ((bf16_t*)(ws + OFF_XB))
#define W_BIG ((bf16_t*)(ws + OFF_BIG))
#define W_OSP ((bf16_t*)(ws + OFF_BIG + 256 * MiB))
#define W_WIN ((bf16_t*)(ws + OFF_WIN))
#define W_WOA ((bf16_t*)(ws + OFF_WOA))
#define W_WOS ((bf16_t*)(ws + OFF_WOS))
#define W_WP ((bf16_t*)(ws + OFF_WP))
#define W_WG ((bf16_t*)(ws + OFF_WG))
#define W_PB ((bf16_t*)(ws + OFF_PB))
#define W_SS ((float*)(ws + OFF_SS))
#define W_VST ((float*)(ws + OFF_VST))
#define W_WSB ((bf16_t*)(ws + OFF_WSB))

__global__ __launch_bounds__(512) void mega_fwd(Params P_unused) {
    extern __shared__ __attribute__((aligned(16))) char lds[];
    cg::grid_group grid = cg::this_grid();
    const int G = gridDim.x;
    __shared__ uint4 xb_words;
    if (threadIdx.x == 0) xb_words = make_uint4(0u, 0u, 0u, 0u);
    {
        KP
        for (int jl = 0; jl < 2; ++jl) {
            conv_T(pp->attn_w_out + (size_t)jl * 1024 * 1024, 1024, 1024, W_WOA + (size_t)jl * 1024 * 1024, nullptr, 0, 1.f, lds);
            conv_T(pp->sgu_w_out + (size_t)jl * 2048 * 1024, 2048, 1024, W_WOS + (size_t)jl * 1024 * 2048, nullptr, 0, 1.f, lds);
        }
        for (int i = 0; i < 4; ++i) {
            conv_T(pp->ple_proj + (size_t)i * 256 * 1024, 256, 1024, W_WP + (size_t)i * 1024 * 256, nullptr, 0, 1.f, lds);
            conv_T(pp->ple_gate + (size_t)i * 1024 * 1024, 1024, 1024, W_WG + (size_t)i * 1024 * 1024, nullptr, 0, 1.f, lds);
        }
        if (blockIdx.x == 0) { unsigned* bar = (unsigned*)(ws + OFF_BAR); for (int i = threadIdx.x; i < XCD_BAR_WORDS; i += 512) bar[i] = 0u; }
        conv_T(pp->attn_w_in, 1024, 4096, W_WIN, pp->attn_norm, 1024, 0.125f * LOG2E, lds);
        { const int tid = otid(); const float* wsrc = pp->w_s; bf16_t* wdst = W_WSB;
          for (size_t e = (size_t)blockIdx.x * 512 + tid; e < (size_t)2 * 8 * 128 * 128; e += (size_t)G * 512) {
              const int s = (int)(e & 127), t = (int)((e >> 7) & 127);
              wdst[e] = (s <= t) ? f2bf(wsrc[e]) : (bf16_t)0; } }
        { const int tid = otid(), wid = tid >> 6, lane = tid & 63; const float* x = pp->x; bf16_t* XB = W_XB; float* SS = W_SS;
          for (int row = blockIdx.x * 8 + wid; row < T_; row += G * 8) {
              const float* xr = x + (size_t)row * 1024; float sq = 0.f;
#pragma unroll
              for (int i = 0; i < 4; ++i) { const f32x4 v = *(const f32x4*)(xr + i * 256 + lane * 4); sq += (v[0] * v[0] + v[1] * v[1]) + (v[2] * v[2] + v[3] * v[3]);
                  st_bf4(XB + (size_t)row * 1024 + i * 256 + lane * 4, v); }
              sq = wave_sum(sq);
              if (lane < 16) SS[(size_t)row * 16 + lane] = (lane == 0) ? sq : 0.f; } }
    }
    grid.sync();
    XcdBarrier xb;
    { KP xb = xcd_barrier_post((unsigned*)(ws + OFF_BAR), (volatile LAS unsigned*)&xb_words); }

#pragma unroll 1
    for (int layer = 0; layer < 4; ++layer) {
        const int jl = layer >> 1;
        { KP conv_flat(pp->p + (size_t)layer * T_ * 256, W_PB, (size_t)T_ * 256); }
        if ((layer & 1) == 0) {
            { KP EpiQKVG epi{W_BIG, W_SS}; gemm_phase(lds, W_XB, 1024, W_WIN, 1024, 1024, T_, 4096, epi); }
            xcd_barrier(xb);
            for (int rep = 0; rep < PROBE_ATTN_REPS; ++rep) {
                KP
                float lam; const int lane = otid() & 63;
                const float li = (layer == 0 ? pp->lam_init0 : pp->lam_init2);
                { const float a = pp->lq1[jl * 64 + lane] * pp->lk1[jl * 64 + lane], b2 = pp->lq2[jl * 64 + lane] * pp->lk2[jl * 64 + lane];
                  lam = __expf(wave_sum(a)) - __expf(wave_sum(b2)) + li; }
                const float oscale = 1.f - li;
                const float* sg = pp->subln + jl * 128;
                bf16_t* BIG = W_BIG; bf16_t* OSP = W_OSP;
#pragma unroll 1
                for (int pr = blockIdx.x; pr < 1024; pr += G) {
                    const int c = pr & 255, i = pr >> 8, xcd = c & 7, slot = c >> 3;
                    const int bh = i * 16 + xcd * 2 + (slot >> 4), pq = slot & 15, b = bh >> 3, h = bh & 7;
                    const float slope2 = exp2f(-(float)(h + 1)) * LOG2E;
                    attn_unit(BIG, OSP, b, h, 31 - pq, lam, slope2, sg, oscale, lds);
                    attn_unit(BIG, OSP, b, h, pq, lam, slope2, sg, oscale, lds);
                }
            }
            xcd_barrier(xb);
            { KP EpiRes epi{layer == 0 ? pp->x : pp->out, pp->out, W_BIG + 2048, 4096}; gemm_phase(lds, W_OSP, 1024, W_WOA + (size_t)jl * 1024 * 1024, 1024, 1024, T_, 1024, epi); }
            { KP EpiE epi{W_BIG + 1024, 4096}; gemm_phase(lds, W_PB, 256, W_WP + (size_t)layer * 1024 * 256, 256, 256, T_, 1024, epi); }
            xcd_barrier(xb);
            { KP conv_T(pp->sgu_w_in + (size_t)jl * 1024 * 6144, 1024, 6144, W_WIN, pp->sgu_norm + jl * 1024, 0, 1.f, lds); }
            { KP EpiGate epi{pp->out, W_BIG + 1024, 4096, W_XB, W_SS}; gemm_phase(lds, W_BIG + 2048, 4096, W_WG + (size_t)layer * 1024 * 1024, 1024, 1024, T_, 1024, epi); }
            xcd_barrier(xb);
        } else {
            { KP EpiSguIn epi{W_BIG, W_SS, W_VST}; gemm_phase(lds, W_XB, 1024, W_WIN, 1024, 1024, T_, 6144, epi); }
            xcd_barrier(xb);
            { KP
              const bf16_t* wsb = W_WSB + (size_t)jl * 8 * 128 * 128; const float* bs = pp->b_s + jl * 8 * 128; const float* lg = pp->ln_g + jl * 2048; const float* lb = pp->ln_b + jl * 2048;
              bf16_t* BIG = W_BIG; const float* VST = W_VST;
#pragma unroll 1
              for (int u = blockIdx.x; u < 2048; u += G) sgu_unit(BIG, u >> 3, u & 7, wsb, bs, lg, lb, VST, lds); }
            xcd_barrier(xb);
            { KP EpiRes epi{pp->out, pp->out, W_BIG + 4096, 6144}; gemm_phase(lds, W_BIG, 6144, W_WOS + (size_t)jl * 1024 * 2048, 2048, 2048, T_, 1024, epi); }
            { KP EpiE epi{W_BIG + 2048, 6144}; gemm_phase(lds, W_PB, 256, W_WP + (size_t)layer * 1024 * 256, 256, 256, T_, 1024, epi); }
            xcd_barrier(xb);
            if (layer + 1 < 4) { KP conv_T(pp->attn_w_in + (size_t)(jl + 1) * 1024 * 4096, 1024, 4096, W_WIN, pp->attn_norm + (jl + 1) * 1024, 1024, 0.125f * LOG2E, lds); }
            { KP EpiGate epi{pp->out, W_BIG + 2048, 6144, W_XB, W_SS}; gemm_phase(lds, W_BIG + 4096, 6144, W_WG + (size_t)layer * 1024 * 1024, 1024, 1024, T_, 1024, epi); }
            xcd_barrier(xb);
        }
    }
    {
        KP
        const int tid = otid(), wid = tid >> 6, lane = tid & 63; float* XR = pp->out; const float* SS = W_SS; const float* fg = pp->final_norm;
        for (int row = blockIdx.x * 8 + wid; row < T_; row += G * 8) {
            const float rs = rs_from_ss(SS, row);
            float* xr = XR + (size_t)row * 1024;
#pragma unroll
            for (int i = 0; i < 4; ++i) { const int c = i * 256 + lane * 4; const f32x4 v = *(const f32x4*)(xr + c), gg = *(const f32x4*)(fg + c);
                *(f32x4*)(xr + c) = v * rs * gg; }
        }
    }
}

extern "C" void kernel_launch(void* const* d_in, const int* in_sizes, int n_in, void* d_out, int out_size, void* d_ws, size_t ws_size, hipStream_t stream) {
    static int grid_blocks = 0;
    if (!grid_blocks) {
        int dev = 0, cus = 0, per_cu = 0;
        hipGetDevice(&dev);
        hipDeviceGetAttribute(&cus, hipDeviceAttributeMultiprocessorCount, dev);
        hipFuncSetAttribute((const void*)mega_fwd, hipFuncAttributeMaxDynamicSharedMemorySize, LDS_BYTES);
        hipOccupancyMaxActiveBlocksPerMultiprocessor(&per_cu, mega_fwd, 512, LDS_BYTES);
        if (per_cu < 1) per_cu = 1;
        grid_blocks = cus * 1;
    }
    Params P{};
    const float** pp = (const float**)&P;
    for (int i = 0; i < 20; ++i) pp[i] = (const float*)d_in[i];
    P.out = (float*)d_out; P.ws = (char*)d_ws;
    P.lam_init0 = 0.2f; P.lam_init2 = (float)(0.8 - 0.6 * 0.54881163609402643);
    void* args[] = {&P};
    hipError_t e = hipLaunchCooperativeKernel((void*)mega_fwd, dim3(grid_blocks), dim3(512), args, LDS_BYTES, stream);
    if (e != hipSuccess) fprintf(stderr, "cooperative launch failed: %s (grid %d)\n", hipGetErrorString(e), grid_blocks);
}
```

```cpp
#include <hip/hip_runtime.h>
#include <hip/hip_cooperative_groups.h>
#include <cstdio>
#include <cstdint>
namespace cg = cooperative_groups;

#define DI __device__ __forceinline__
typedef unsigned short bf16_t;
typedef short bf16x8 __attribute__((ext_vector_type(8)));
typedef short s16x4 __attribute__((ext_vector_type(4)));
typedef float f32x2 __attribute__((ext_vector_type(2)));
typedef float f32x4 __attribute__((ext_vector_type(4)));
typedef float f32x16 __attribute__((ext_vector_type(16)));
typedef __bf16 bf16x2v __attribute__((ext_vector_type(2)));
typedef unsigned u32x2 __attribute__((ext_vector_type(2)));
typedef unsigned u32x4 __attribute__((ext_vector_type(4)));

constexpr int T_ = 32768, S_ = 4096;
constexpr size_t MiB = 1024 * 1024;
constexpr size_t OFF_XB = 0, OFF_BIG = 64 * MiB, OFF_WIN = 448 * MiB, OFF_WOA = 460 * MiB, OFF_WOS = 464 * MiB, OFF_WP = 472 * MiB,
                 OFF_WG = 474 * MiB, OFF_PB = 482 * MiB, OFF_SS = 498 * MiB, OFF_VST = 500 * MiB, OFF_WSB = 508 * MiB, OFF_BAR = 509 * MiB;
constexpr int LDS_BYTES = 128 * 1024;
#define STAGGER_TICKS 0
#ifndef PROBE_MASK
#define PROBE_MASK 0
#endif
#define PH_BEGIN(id) unsigned long long _pt0 = 0; if (PROBE_MASK & (1 << (id))) _pt0 = __builtin_amdgcn_s_memrealtime();
#define PH_END(id) if (PROBE_MASK & (1 << (id))) { const unsigned long long _pt1 = __builtin_amdgcn_s_memrealtime(); while (__builtin_amdgcn_s_memrealtime() - _pt1 < _pt1 - _pt0) __builtin_amdgcn_s_sleep(8); }
#ifndef PROBE_ATTN_REPS
#define PROBE_ATTN_REPS 1
#endif
#define LOG2E 1.4426950408889634f

struct Params {
    const float *x, *p, *attn_norm, *attn_w_in, *lq1, *lk1, *lq2, *lk2, *subln, *attn_w_out, *sgu_norm, *sgu_w_in, *ln_g, *ln_b, *w_s, *b_s,
        *sgu_w_out, *ple_proj, *ple_gate, *final_norm;
    float* out;
    char* ws;
    float lam_init0, lam_init2;
};

DI int otid() { int t = threadIdx.x; asm volatile("" : "+v"(t)); return t; }
DI float sum_xor32(float v) { const u32x2 r = __builtin_amdgcn_permlane32_swap(__float_as_uint(v), __float_as_uint(v), false, false); return __uint_as_float(r[0]) + __uint_as_float(r[1]); }
DI float max_xor32(float v) { const u32x2 r = __builtin_amdgcn_permlane32_swap(__float_as_uint(v), __float_as_uint(v), false, false); return fmaxf(__uint_as_float(r[0]), __uint_as_float(r[1])); }
DI float sum_xor16(float v) { const u32x2 r = __builtin_amdgcn_permlane16_swap(__float_as_uint(v), __float_as_uint(v), false, false); return __uint_as_float(r[0]) + __uint_as_float(r[1]); }
DI unsigned pk2(float a, float b) { f32x2 v = {a, b}; return __builtin_bit_cast(unsigned, __builtin_convertvector(v, bf16x2v)); }
DI bf16_t f2bf(float a) { return (bf16_t)(pk2(a, 0.f) & 0xffffu); }
DI float bflo(unsigned u) { return __uint_as_float(u << 16); }
DI float bfhi(unsigned u) { return __uint_as_float(u & 0xffff0000u); }
DI float sigmoidf_(float x) { return __builtin_amdgcn_rcpf(1.f + __builtin_amdgcn_exp2f(-x * LOG2E)); }
DI float siluf_(float x) { return x * sigmoidf_(x); }
DI f32x2 gelu_pk(f32x2 v) {
    const f32x2 av = __builtin_elementwise_abs(v), d = av * 0.2316418882f + 1.0f;
    f32x2 t; t.x = __builtin_amdgcn_rcpf(d.x); t.y = __builtin_amdgcn_rcpf(d.y);
    f32x2 q = t * 0.5307027145f + (-0.7265760135f); q = q * t + 0.7107068705f; q = q * t + (-0.142248368f); q = q * t + 0.127414796f; q = q * t;
    const f32x2 s = (v * v) * (-0.72134752044f);
    f32x2 e; e.x = __builtin_amdgcn_exp2f(s.x); e.y = __builtin_amdgcn_exp2f(s.y);
    const f32x2 m = v * (q * e), r = v - m;
    f32x2 o; o.x = v.x < 0.f ? m.x : r.x; o.y = v.y < 0.f ? m.y : r.y; return o;
}
DI int fxr(int row) { return ((row & 3) << 2) | ((row >> 2) & 3); }

DI void conv_item(const float* src, int K, int N, bf16_t* dst, const float* gain, int nscale, float cs, int item) {
    const int n = item % N, kb = item / N;
    const float* sp = src + (size_t)(kb * 32) * N + n;
    float v[32];
#pragma unroll
    for (int i = 0; i < 32; ++i) v[i] = sp[(size_t)i * N];
    const float sc = (n < nscale) ? cs : 1.f;
    if (gain) {
#pragma unroll
        for (int i = 0; i < 32; ++i) v[i] *= gain[kb * 32 + i];
    }
    bf16_t* dp = dst + (size_t)n * K + kb * 32;
#pragma unroll
    for (int q = 0; q < 4; ++q) { u32x4 w; w.x = pk2(v[8 * q] * sc, v[8 * q + 1] * sc); w.y = pk2(v[8 * q + 2] * sc, v[8 * q + 3] * sc);
        w.z = pk2(v[8 * q + 4] * sc, v[8 * q + 5] * sc); w.w = pk2(v[8 * q + 6] * sc, v[8 * q + 7] * sc); *(u32x4*)(dp + 8 * q) = w; }
}
DI void conv_T_part(const float* src, int K, int N, bf16_t* dst, const float* gain, int nscale, float cs, int lt, int nt, int part, int nparts) {
    const int total = N * (K >> 5), lo = (int)((long)total * part / nparts), hi = (int)((long)total * (part + 1) / nparts);
    for (int item = lo + blockIdx.x * nt + lt; item < hi; item += gridDim.x * nt) conv_item(src, K, N, dst, gain, nscale, cs, item);
}
DI void conv_flat_part(const float* src, bf16_t* dst, size_t n, int lt, int nt, int part, int nparts) {
    const size_t nch = n / 8, lo = nch * part / nparts, hi = nch * (part + 1) / nparts;
    for (size_t c = lo + (size_t)blockIdx.x * nt + lt; c < hi; c += (size_t)gridDim.x * nt) {
        const f32x4 a = *(const f32x4*)(src + c * 8), b = *(const f32x4*)(src + c * 8 + 4);
        u32x4 w; w.x = pk2(a[0], a[1]); w.y = pk2(a[2], a[3]); w.z = pk2(b[0], b[1]); w.w = pk2(b[2], b[3]);
        *(u32x4*)(dst + c * 8) = w;
    }
}
DI void conv_T(const float* src, int K, int N, bf16_t* dst, const float* gain, int nscale, float cs, char*) {
    const int tx = otid();
    const int total = N * (K >> 5);
    for (int item = blockIdx.x * 512 + tx; item < total; item += gridDim.x * 512) conv_item(src, K, N, dst, gain, nscale, cs, item);
}
DI void conv_flat(const float* src, bf16_t* dst, size_t n) {
    const size_t nch = n / 8;
    const int tx = otid();
    for (size_t c = (size_t)blockIdx.x * 512 + tx; c < nch; c += (size_t)gridDim.x * 512) {
        const f32x4 a = *(const f32x4*)(src + c * 8), b = *(const f32x4*)(src + c * 8 + 4);
        u32x4 w; w.x = pk2(a[0], a[1]); w.y = pk2(a[2], a[3]); w.z = pk2(b[0], b[1]); w.w = pk2(b[2], b[3]);
        *(u32x4*)(dst + c * 8) = w;
    }
}

typedef __attribute__((address_space(3))) unsigned char lds_uc;
constexpr int HTB = 128 * 64 * 2;
DI int lds_byte(int r, int c) { const int st = (r >> 4) * 2 + (c >> 5), rr = r & 15, cc = c & 31, ob = rr * 64 + cc * 2; return st * 1024 + (ob ^ (((ob >> 9) & 1) << 5)); }
DI void stage_rc(int b, int& R, int& C) { const int st = b / 1024, sb = b % 1024, swz = sb ^ (((sb >> 9) & 1) << 5); R = (st >> 1) * 16 + swz / 64; C = (st & 1) * 32 + (swz % 64) / 2; }
#ifndef WGM_
#define WGM_ 4
#endif
struct Unit { int pm, pn; };
struct StaticOrder {
    int nM, nN, nwg, G, c;
    DI void init(int M, int N, int G_, int c_) { nM = M / 256; nN = N / 256; nwg = nM * nN; G = G_; c = c_; }
    DI bool next(int i, Unit& u) const {
        const long L = (long)i * G + c; if (L >= nwg) return false;
        int wgid = (int)L; { const int q = nwg / 8, r = nwg % 8, xcd = wgid % 8, off = wgid / 8; wgid = (xcd < r ? xcd * (q + 1) : r * (q + 1) + (xcd - r) * q) + off; }
        const int nig = WGM_ * nN, gid = wgid / nig, fm = gid * WGM_, gsz = (nM - fm) < WGM_ ? (nM - fm) : WGM_;
        u.pm = fm + ((wgid % nig) % gsz); u.pn = (wgid % nig) / gsz; return true;
    }
};

template <class Epi>
DI void gemm_phase(char* lds_generic, const bf16_t* A, int lda, const bf16_t* Bt, int ldb, int K, int M, int N, const Epi& E, int stagger_ticks = 0) {
    lds_uc* lds = (lds_uc*)lds_generic;
    const int tid = otid(), wid = __builtin_amdgcn_readfirstlane(tid >> 6), lane = tid & 63, wr = wid >> 2, wc = wid & 3, fr = lane & 15, fq = lane >> 4;
    StaticOrder S; S.init(M, N, gridDim.x, blockIdx.x);
    const int nt = K / 64;
    unsigned voffA[2], voffB[2];
#pragma unroll
    for (int i = 0; i < 2; ++i) { int R, C; stage_rc(tid * 16 + i * 8192, R, C); const int rho = R & 31, Rb = (R & ~31) + 8 * ((rho & 15) >> 2) + 4 * (rho >> 4) + (rho & 3);
        voffA[i] = (unsigned)(R * lda + C) * 2u; voffB[i] = (unsigned)(Rb * ldb + C) * 2u; }
    const size_t kstep = 128;
    const size_t hstepA = (size_t)128 * lda * 2, hstepB = (size_t)128 * ldb * 2, tstepA = 2 * hstepA, tstepB = 2 * hstepB;
    const unsigned ldsw = (unsigned)wid * 1024u;
    const int aoff = lds_byte(wr * 64 + fr, fq * 8), boff = lds_byte(wc * 32 + fr, fq * 8);
#define PG8_SA(b, h) (((b) * 2 + (h)) * HTB)
#define PG8_SB(b, h) ((4 + (b) * 2 + (h)) * HTB)
#define PG8_STAGE(bufoff, gbase, voff) do { _Pragma("unroll") for (int _i = 0; _i < 2; ++_i) \
        __builtin_amdgcn_global_load_lds((const unsigned*)((const char*)(gbase) + (voff)[_i]), (__attribute__((address_space(3))) unsigned*)(lds + (bufoff) + ldsw + _i * 8192), 16, 0, 0); } while (0)
#define PG8_LDA(dst, b, h) do { _Pragma("unroll") for (int m = 0; m < 4; ++m) _Pragma("unroll") for (int k = 0; k < 2; ++k) dst[m][k] = *(const __attribute__((address_space(3))) bf16x8*)(lds + PG8_SA(b, h) + aoff + m * 2048 + k * 1024); } while (0)
#define PG8_LDB(dst, b, h) do { _Pragma("unroll") for (int n = 0; n < 2; ++n) _Pragma("unroll") for (int k = 0; k < 2; ++k) dst[n][k] = *(const __attribute__((address_space(3))) bf16x8*)(lds + PG8_SB(b, h) + boff + n * 2048 + k * 1024); } while (0)
#define PG8_MMA(ai, bj, At, Bt_) do { __builtin_amdgcn_s_setprio(1); _Pragma("unroll") for (int m = 0; m < 4; ++m) _Pragma("unroll") for (int n = 0; n < 2; ++n) _Pragma("unroll") for (int k = 0; k < 2; ++k) \
        acc[ai][bj][m][n] = __builtin_amdgcn_mfma_f32_16x16x32_bf16(Bt_[n][k], At[m][k], acc[ai][bj][m][n], 0, 0, 0); __builtin_amdgcn_s_setprio(0); } while (0)
#define PG8_WAIT_V(n) asm volatile("s_waitcnt vmcnt(" #n ")" ::: "memory")
#define PG8_WAIT_L(n) asm volatile("s_waitcnt lgkmcnt(" #n ")" ::: "memory")
#define PG8_BAR __builtin_amdgcn_s_barrier()
#define PG8_SCHED __builtin_amdgcn_sched_barrier(0)
    Unit cur, nxt; int ui = 0;
    __syncthreads();
    if (!S.next(0, cur)) return;
    PG8_WAIT_V(0);
    if (stagger_ticks) {
        const unsigned long long t0 = __builtin_amdgcn_s_memrealtime(), dl = (unsigned long long)(((blockIdx.x >> 3) & 3) * stagger_ticks);
        while (__builtin_amdgcn_s_memrealtime() - t0 < dl) __builtin_amdgcn_s_sleep(8);
    }
    f32x4 acc[2][2][4][2];
#pragma unroll
    for (int a = 0; a < 2; ++a)
#pragma unroll
        for (int b = 0; b < 2; ++b)
#pragma unroll
            for (int m = 0; m < 4; ++m)
#pragma unroll
                for (int n = 0; n < 2; ++n) acc[a][b][m][n] = (f32x4){0.f, 0.f, 0.f, 0.f};
    bf16x8 At[4][2], B0[2][2], B1[2][2];
    const char* cA = (const char*)A + (size_t)cur.pm * tstepA; const char* cB = (const char*)Bt + (size_t)cur.pn * tstepB;
    PG8_STAGE(PG8_SB(0, 0), cB, voffB); PG8_STAGE(PG8_SB(0, 1), cB + hstepB, voffB); PG8_STAGE(PG8_SA(0, 0), cA, voffA); PG8_STAGE(PG8_SA(0, 1), cA + hstepA, voffA);
    if (wr == 1) PG8_BAR;
    PG8_WAIT_V(2); PG8_BAR;
    PG8_STAGE(PG8_SB(1, 0), cB + kstep, voffB); PG8_STAGE(PG8_SA(1, 0), cA + kstep, voffA); PG8_STAGE(PG8_SB(1, 1), cB + hstepB + kstep, voffB);
    PG8_WAIT_V(6); PG8_BAR;
    for (;;) {
        const bool has_next = S.next(ui + 1, nxt);
        const char* nA = has_next ? (const char*)A + (size_t)nxt.pm * tstepA : cA; const char* nB = has_next ? (const char*)Bt + (size_t)nxt.pn * tstepB : cB;
#pragma unroll 1
        for (int t = 0; t < nt; t += 2) {
            const bool last = (t == nt - 2);
            const char* a1 = cA + (size_t)(t + 1) * kstep;
            const char* a2 = last ? nA : cA + (size_t)(t + 2) * kstep; const char* b2 = last ? nB : cB + (size_t)(t + 2) * kstep;
            const char* a3 = a2 + kstep; const char* b3 = b2 + kstep;
            PG8_LDB(B0, 0, 0); PG8_LDB(B1, 0, 1); PG8_SCHED; PG8_LDA(At, 0, 0); PG8_STAGE(PG8_SA(1, 1), a1 + hstepA, voffA);
            PG8_WAIT_V(8); PG8_WAIT_L(0); PG8_BAR; PG8_MMA(0, 0, At, B0); PG8_MMA(0, 1, At, B1); PG8_BAR; PG8_SCHED;
            PG8_LDA(At, 0, 1); PG8_STAGE(PG8_SB(0, 0), b2, voffB); PG8_STAGE(PG8_SB(0, 1), b2 + hstepB, voffB); PG8_STAGE(PG8_SA(0, 0), a2, voffA);
            PG8_WAIT_V(8); PG8_WAIT_L(0); PG8_BAR; PG8_MMA(1, 0, At, B0); PG8_MMA(1, 1, At, B1); PG8_BAR; PG8_SCHED;
            PG8_LDB(B0, 1, 0); PG8_LDB(B1, 1, 1); PG8_SCHED; PG8_LDA(At, 1, 0); PG8_STAGE(PG8_SA(0, 1), a2 + hstepA, voffA);
            PG8_WAIT_V(8); PG8_WAIT_L(0); PG8_BAR; PG8_MMA(0, 0, At, B0); PG8_MMA(0, 1, At, B1); PG8_BAR; PG8_SCHED;
            PG8_LDA(At, 1, 1); PG8_STAGE(PG8_SB(1, 0), b3, voffB); PG8_STAGE(PG8_SB(1, 1), b3 + hstepB, voffB); PG8_STAGE(PG8_SA(1, 0), a3, voffA);
            PG8_WAIT_V(8); PG8_WAIT_L(0); PG8_BAR; PG8_MMA(1, 0, At, B0); PG8_MMA(1, 1, At, B1); PG8_BAR; PG8_SCHED;
        }
        if (wr == 0) PG8_BAR;
        E(acc, cur.pm, cur.pn, wr, wc, fr, fq);
        if (!has_next) break;
#pragma unroll
        for (int a = 0; a < 2; ++a)
#pragma unroll
            for (int b = 0; b < 2; ++b)
#pragma unroll
                for (int m = 0; m < 4; ++m)
#pragma unroll
                    for (int n = 0; n < 2; ++n) acc[a][b][m][n] = (f32x4){0.f, 0.f, 0.f, 0.f};
        cur = nxt; cA = nA; cB = nB; ++ui;
        if (wr == 1) PG8_BAR;
    }
    PG8_WAIT_V(0);
    PG8_BAR;
}

#define EPI_ARGS const f32x4 (&acc)[2][2][4][2], int pm, int pn, int wr, int wc, int fr, int fq
#define ROW_OF(ai, m) (pm * 256 + (ai) * 128 + wr * 64 + (m) * 16 + fr)
#define COL_OF(bj) (pn * 256 + (bj) * 128 + wc * 32 + fq * 8)
DI float quad_sum(float v) { return sum_xor32(sum_xor16(v)); }
DI float rs_from_ss(const float* ss, int row) {
    const f32x4* p = (const f32x4*)(ss + (size_t)row * 16); const f32x4 s = (p[0] + p[1]) + (p[2] + p[3]);
    return rsqrtf(((s[0] + s[1]) + (s[2] + s[3])) * (1.f / 1024.f) + 1e-6f); }
DI float rs_from_ss_q(const float* ss, int row, int fq) {
    const f32x4 s = *(const f32x4*)(ss + (size_t)row * 16 + fq * 4);
    return rsqrtf(quad_sum((s[0] + s[1]) + (s[2] + s[3])) * (1.f / 1024.f) + 1e-6f); }
DI void st_bf4(bf16_t* p, f32x4 v) { u32x2 w; w.x = pk2(v[0], v[1]); w.y = pk2(v[2], v[3]); *(u32x2*)p = w; }
DI void st_bf8(bf16_t* p, f32x4 a, f32x4 b) { u32x4 w; w.x = pk2(a[0], a[1]); w.y = pk2(a[2], a[3]); w.z = pk2(b[0], b[1]); w.w = pk2(b[2], b[3]); *(u32x4*)p = w; }
DI void ld_bf8(const bf16_t* p, f32x4& a, f32x4& b) { const u32x4 w = *(const u32x4*)p; a[0] = bflo(w.x); a[1] = bfhi(w.x); a[2] = bflo(w.y); a[3] = bfhi(w.y); b[0] = bflo(w.z); b[1] = bfhi(w.z); b[2] = bflo(w.w); b[3] = bfhi(w.w); }
DI float sum4(f32x4 v) { return (v[0] + v[1]) + (v[2] + v[3]); }
DI float sumsq4(f32x4 v) { return (v[0] * v[0] + v[1] * v[1]) + (v[2] * v[2] + v[3] * v[3]); }
DI f32x4 gelu4(f32x4 v) { const f32x2 a = gelu_pk((f32x2){v[0], v[1]}), b = gelu_pk((f32x2){v[2], v[3]}); return (f32x4){a.x, a.y, b.x, b.y}; }
DI f32x4 sig4(f32x4 g) { return (f32x4){sigmoidf_(g[0]), sigmoidf_(g[1]), sigmoidf_(g[2]), sigmoidf_(g[3])}; }

struct EpiQKVG {
    bf16_t* out; const float* ss;
    DI void operator()(EPI_ARGS) const {
#pragma unroll
        for (int ai = 0; ai < 2; ++ai)
#pragma unroll
            for (int m = 0; m < 4; ++m) { const int row = ROW_OF(ai, m); const float rs = rs_from_ss_q(ss, row, fq);
#pragma unroll
                for (int bj = 0; bj < 2; ++bj) st_bf8(out + (size_t)row * 4096 + COL_OF(bj), acc[ai][bj][m][0] * rs, acc[ai][bj][m][1] * rs); }
    }
};
struct EpiSguIn {
    bf16_t* z; const float* ss; float* vst;
    DI void operator()(EPI_ARGS) const {
        const bool do_gelu = pn < 16, do_stats = (pn >= 8) && (pn < 16);
#pragma unroll
        for (int ai = 0; ai < 2; ++ai)
#pragma unroll
            for (int m = 0; m < 4; ++m) { const int row = ROW_OF(ai, m); const float rs = rs_from_ss_q(ss, row, fq); float s1 = 0.f, s2 = 0.f;
#pragma unroll
                for (int bj = 0; bj < 2; ++bj) { f32x4 v0 = acc[ai][bj][m][0] * rs, v1 = acc[ai][bj][m][1] * rs;
                    if (do_gelu) { v0 = gelu4(v0); v1 = gelu4(v1); }
                    s1 += sum4(v0) + sum4(v1); s2 += sumsq4(v0) + sumsq4(v1);
                    st_bf8(z + (size_t)row * 6144 + COL_OF(bj), v0, v1); }
                if (do_stats) { s1 = quad_sum(s1); s2 = quad_sum(s2);
                    if (fq == 0) *(f32x2*)(vst + ((size_t)row * 32 + (pn - 8) * 4 + wc) * 2) = (f32x2){s1, s2}; } }
    }
};
struct EpiRes {
    const bf16_t* xin; bf16_t* xb; int ldxb;
    DI void operator()(EPI_ARGS) const {
#pragma unroll
        for (int ai = 0; ai < 2; ++ai)
#pragma unroll
            for (int m = 0; m < 4; ++m) { const int row = ROW_OF(ai, m);
#pragma unroll
                for (int bj = 0; bj < 2; ++bj) { const int col = COL_OF(bj); f32x4 x0, x1; ld_bf8(xin + (size_t)row * 1024 + col, x0, x1);
                    st_bf8(xb + (size_t)row * ldxb + col, x0 + acc[ai][bj][m][0], x1 + acc[ai][bj][m][1]); } }
    }
};
struct EpiE {
    bf16_t* e; int lde;
    DI void operator()(EPI_ARGS) const {
#pragma unroll
        for (int ai = 0; ai < 2; ++ai)
#pragma unroll
            for (int m = 0; m < 4; ++m) { const int row = ROW_OF(ai, m);
#pragma unroll
                for (int bj = 0; bj < 2; ++bj) st_bf8(e + (size_t)row * lde + COL_OF(bj), acc[ai][bj][m][0], acc[ai][bj][m][1]); }
    }
};
struct EpiGate {
    const bf16_t* xm; int ldm; const bf16_t* e; int lde; bf16_t* xb; float* ss;
    DI void operator()(EPI_ARGS) const {
#pragma unroll
        for (int ai = 0; ai < 2; ++ai)
#pragma unroll
            for (int m = 0; m < 4; ++m) { const int row = ROW_OF(ai, m); float s2 = 0.f;
#pragma unroll
                for (int bj = 0; bj < 2; ++bj) { const int col = COL_OF(bj); f32x4 x0, x1, e0, e1;
                    ld_bf8(xm + (size_t)row * ldm + col, x0, x1); ld_bf8(e + (size_t)row * lde + col, e0, e1);
                    const f32x4 v0 = x0 + e0 * sig4(acc[ai][bj][m][0]), v1 = x1 + e1 * sig4(acc[ai][bj][m][1]);
                    s2 += sumsq4(v0) + sumsq4(v1);
                    st_bf8(xb + (size_t)row * 1024 + col, v0, v1); }
                s2 = quad_sum(s2);
                if (fq == 0) ss[(size_t)row * 16 + pn * 4 + wc] = s2; }
    }
};

template <int OFF> DI void tr8_issue_off(s16x4 (&lo)[4], s16x4 (&hi)[4], const unsigned (&a)[8]) {
    asm volatile("ds_read_b64_tr_b16 %0, %8 offset:%16\n\tds_read_b64_tr_b16 %1, %9 offset:%16\n\tds_read_b64_tr_b16 %2, %10 offset:%16\n\tds_read_b64_tr_b16 %3, %11 offset:%16\n\t"
                 "ds_read_b64_tr_b16 %4, %12 offset:%16\n\tds_read_b64_tr_b16 %5, %13 offset:%16\n\tds_read_b64_tr_b16 %6, %14 offset:%16\n\tds_read_b64_tr_b16 %7, %15 offset:%16"
                 : "=&v"(lo[0]), "=&v"(hi[0]), "=&v"(lo[1]), "=&v"(hi[1]), "=&v"(lo[2]), "=&v"(hi[2]), "=&v"(lo[3]), "=&v"(hi[3])
                 : "v"(a[0]), "v"(a[1]), "v"(a[2]), "v"(a[3]), "v"(a[4]), "v"(a[5]), "v"(a[6]), "v"(a[7]), "i"(OFF) : "memory");
}
template <int N> DI void tr8_wait(s16x4 (&lo)[4], s16x4 (&hi)[4]) {
    if (N == 0) asm volatile("s_waitcnt lgkmcnt(0)" : "+v"(lo[0]), "+v"(hi[0]), "+v"(lo[1]), "+v"(hi[1]), "+v"(lo[2]), "+v"(hi[2]), "+v"(lo[3]), "+v"(hi[3]) :: "memory");
    else asm volatile("s_waitcnt lgkmcnt(8)" : "+v"(lo[0]), "+v"(hi[0]), "+v"(lo[1]), "+v"(hi[1]), "+v"(lo[2]), "+v"(hi[2]), "+v"(lo[3]), "+v"(hi[3]) :: "memory");
}
DI bf16x8 cat8(s16x4 lo, s16x4 hi) { return (bf16x8){lo[0], lo[1], lo[2], lo[3], hi[0], hi[1], hi[2], hi[3]}; }

DI void attn_unit(const bf16_t* big, bf16_t* osp, int b, int h, int qb, float lam, float slope2, const float* subln_g, float oscale, char* lds_generic) {
    lds_uc* lds = (lds_uc*)lds_generic;
    const int tid = otid(), wid = __builtin_amdgcn_readfirstlane(tid >> 6), lane = tid & 63, w = wid & 3, j = wid >> 2, hf = lane >> 5, l32 = lane & 31;
    const int q0 = qb * 128;
    const size_t rowbase = (size_t)b * S_;
    const float NEG_INF = -__builtin_inff();
    bf16x8 qf[4];
    { const bf16_t* Qp = big + (rowbase + q0 + 32 * w + l32) * 4096 + h * 128 + j * 64;
#pragma unroll
      for (int ks = 0; ks < 4; ++ks) qf[ks] = *(const bf16x8*)(Qp + 16 * ks + 8 * hf); }
    f32x16 o[4];
#pragma unroll
    for (int mo = 0; mo < 4; ++mo)
#pragma unroll
        for (int r = 0; r < 16; ++r) o[mo][r] = 0.f;
    float l_run = 0.f;
    const int nkt = 2 * qb + 2;
    const bf16_t* srcK; const bf16_t* srcV0; const bf16_t* srcV1;
    { const int row = tid >> 3, cp = tid & 7; srcK = big + (rowbase + row) * 4096 + 1024 + h * 128 + ((cp ^ ((row >> 1) & 7)) << 3); }
    { const int s0 = tid, row = s0 >> 4, cp = s0 & 15; srcV0 = big + (rowbase + row) * 4096 + 2048 + h * 128 + ((cp ^ fxr(row)) << 3); }
    { const int s1 = tid + 512, row = s1 >> 4, cp = s1 & 15; srcV1 = big + (rowbase + row) * 4096 + 2048 + h * 128 + ((cp ^ fxr(row)) << 3); }
    const unsigned ldsw = (unsigned)wid * 1024u;
#define AT_DMA(kt_, bo_) do { const size_t _ko = (size_t)(kt_) * 64 * 4096; \
        __builtin_amdgcn_global_load_lds((const unsigned*)(srcK + _ko), (__attribute__((address_space(3))) unsigned*)(lds + (bo_) + ldsw), 16, 0, 0); \
        __builtin_amdgcn_global_load_lds((const unsigned*)(srcK + _ko + 64), (__attribute__((address_space(3))) unsigned*)(lds + (bo_) + 8192 + ldsw), 16, 0, 0); \
        __builtin_amdgcn_global_load_lds((const unsigned*)(srcV0 + _ko), (__attribute__((address_space(3))) unsigned*)(lds + (bo_) + 16384 + ldsw), 16, 0, 0); \
        __builtin_amdgcn_global_load_lds((const unsigned*)(srcV1 + _ko), (__attribute__((address_space(3))) unsigned*)(lds + (bo_) + 24576 + ldsw), 16, 0, 0); } while (0)
    const int g_blk = (lane >> 4) & 1, g_q = (lane & 15) >> 2, g_p = lane & 3;
    bf16x8 pf[4];
    unsigned voff[8];
#pragma unroll
    for (int mo = 0; mo < 4; ++mo)
#pragma unroll
        for (int t = 0; t < 2; ++t) { const int row = 8 * t + 4 * hf + g_q, ch = 4 * mo + 2 * g_blk + (g_p >> 1); voff[2 * mo + t] = (unsigned)(row * 256 + ((ch ^ fxr(row)) << 4) + 8 * (g_p & 1)); }
    f32x16 st[2];
    float ps_acc = 0.f;
    auto exp_chunk = [&](int kk) {
        const int mt = kk >> 1, s8 = (kk & 1) * 8; float e[8];
#pragma unroll
        for (int i = 0; i < 8; ++i) e[i] = __builtin_amdgcn_exp2f(st[mt][s8 + i]);
        ps_acc += ((e[0] + e[1]) + (e[2] + e[3])) + ((e[4] + e[5]) + (e[6] + e[7]));
        u32x4 pw; pw.x = pk2(e[0], e[1]); pw.y = pk2(e[2], e[3]); pw.z = pk2(e[4], e[5]); pw.w = pk2(e[6], e[7]);
        pf[kk] = __builtin_bit_cast(bf16x8, pw);
    };
    auto do_pv = [&](int bo) {
        const unsigned vbase = (unsigned)(uintptr_t)(lds + bo + 16384);
        s16x4 la[4], ha[4]; unsigned ad[8];
#pragma unroll
        for (int i = 0; i < 8; ++i) ad[i] = vbase + voff[i];
        tr8_issue_off<0>(la, ha, ad); exp_chunk(0); tr8_wait<0>(la, ha);
#pragma unroll
        for (int mo = 0; mo < 4; ++mo) o[mo] = __builtin_amdgcn_mfma_f32_32x32x16_bf16(cat8(la[mo], ha[mo]), pf[0], o[mo], 0, 0, 0);
        asm volatile("s_nop 7\n\ts_nop 7" ::: "memory");
        tr8_issue_off<4096>(la, ha, ad); exp_chunk(1); tr8_wait<0>(la, ha);
#pragma unroll
        for (int mo = 0; mo < 4; ++mo) o[mo] = __builtin_amdgcn_mfma_f32_32x32x16_bf16(cat8(la[mo], ha[mo]), pf[1], o[mo], 0, 0, 0);
        asm volatile("s_nop 7\n\ts_nop 7" ::: "memory");
        tr8_issue_off<8192>(la, ha, ad); exp_chunk(2); tr8_wait<0>(la, ha);
#pragma unroll
        for (int mo = 0; mo < 4; ++mo) o[mo] = __builtin_amdgcn_mfma_f32_32x32x16_bf16(cat8(la[mo], ha[mo]), pf[2], o[mo], 0, 0, 0);
        asm volatile("s_nop 7\n\ts_nop 7" ::: "memory");
        tr8_issue_off<12288>(la, ha, ad); exp_chunk(3); tr8_wait<0>(la, ha);
#pragma unroll
        for (int mo = 0; mo < 4; ++mo) o[mo] = __builtin_amdgcn_mfma_f32_32x32x16_bf16(cat8(la[mo], ha[mo]), pf[3], o[mo], 0, 0, 0);
    };
    auto do_pv_plain = [&](int bo) {
        const unsigned vbase = (unsigned)(uintptr_t)(lds + bo + 16384);
        s16x4 la[4], ha[4]; unsigned ad[8];
#pragma unroll
        for (int i = 0; i < 8; ++i) ad[i] = vbase + voff[i];
        tr8_issue_off<0>(la, ha, ad); tr8_wait<0>(la, ha);
        __builtin_amdgcn_s_setprio(1);
#pragma unroll
        for (int mo = 0; mo < 4; ++mo) o[mo] = __builtin_amdgcn_mfma_f32_32x32x16_bf16(cat8(la[mo], ha[mo]), pf[0], o[mo], 0, 0, 0);
        __builtin_amdgcn_s_setprio(0);
        asm volatile("s_nop 7\n\ts_nop 7" ::: "memory");
        tr8_issue_off<4096>(la, ha, ad); tr8_wait<0>(la, ha);
        __builtin_amdgcn_s_setprio(1);
#pragma unroll
        for (int mo = 0; mo < 4; ++mo) o[mo] = __builtin_amdgcn_mfma_f32_32x32x16_bf16(cat8(la[mo], ha[mo]), pf[1], o[mo], 0, 0, 0);
        __builtin_amdgcn_s_setprio(0);
        asm volatile("s_nop 7\n\ts_nop 7" ::: "memory");
        tr8_issue_off<8192>(la, ha, ad); tr8_wait<0>(la, ha);
        __builtin_amdgcn_s_setprio(1);
#pragma unroll
        for (int mo = 0; mo < 4; ++mo) o[mo] = __builtin_amdgcn_mfma_f32_32x32x16_bf16(cat8(la[mo], ha[mo]), pf[2], o[mo], 0, 0, 0);
        __builtin_amdgcn_s_setprio(0);
        asm volatile("s_nop 7\n\ts_nop 7" ::: "memory");
        tr8_issue_off<12288>(la, ha, ad); tr8_wait<0>(la, ha);
        __builtin_amdgcn_s_setprio(1);
#pragma unroll
        for (int mo = 0; mo < 4; ++mo) o[mo] = __builtin_amdgcn_mfma_f32_32x32x16_bf16(cat8(la[mo], ha[mo]), pf[3], o[mo], 0, 0, 0);
        __builtin_amdgcn_s_setprio(0);
    };
    __syncthreads();
    AT_DMA(nkt - 1, 0);
    asm volatile("s_waitcnt vmcnt(0)" ::: "memory");
    __syncthreads();
    int bo_cur = 0, bo_nxt = 32768, bo_prv = 65536;
    bool first = true, pending = false;
    float m_base = 0.f;
#pragma unroll 1
    for (int kt = nkt - 1; kt >= 0; --kt) {
        if (kt > 0) AT_DMA(kt - 1, bo_nxt);
        const bool skip = (64 * kt > q0 + 32 * w + 31);
        if (j == 1 && pending) do_pv_plain(bo_prv);
        if (!skip) {
            bf16x8 kf[8];
            { const lds_uc* kb = lds + bo_cur + j * 8192;
#pragma unroll
              for (int i = 0; i < 8; ++i) { const int mt = i >> 2, ks = i & 3, row = 32 * mt + l32, ch = 2 * ks + hf;
                  kf[i] = *(const __attribute__((address_space(3))) bf16x8*)(kb + row * 128 + ((ch ^ ((row >> 1) & 7)) << 4)); } }
            const float kbias = slope2 * (float)(64 * kt - q0 + 4 * hf) - m_base;
#pragma unroll
            for (int mt = 0; mt < 2; ++mt)
#pragma unroll
                for (int r = 0; r < 16; ++r) st[mt][r] = kbias + slope2 * (float)(32 * mt + (r & 3) + 8 * (r >> 2));
            __builtin_amdgcn_s_setprio(1);
#pragma unroll
            for (int ks = 0; ks < 4; ++ks)
#pragma unroll
                for (int mt = 0; mt < 2; ++mt) st[mt] = __builtin_amdgcn_mfma_f32_32x32x16_bf16(kf[mt * 4 + ks], qf[ks], st[mt], 0, 0, 0);
            __builtin_amdgcn_s_setprio(0);
            const bool diag = (64 * kt + 63 > q0 + 32 * w);
            if (diag) {
                const int qrel = q0 + 32 * w + l32 - 64 * kt - 4 * hf;
#pragma unroll
                for (int mt = 0; mt < 2; ++mt)
#pragma unroll
                    for (int r = 0; r < 16; ++r) { const int ko = 32 * mt + (r & 3) + 8 * (r >> 2); if (ko > qrel) st[mt][r] = NEG_INF; }
            }
            float tm = NEG_INF;
#pragma unroll
            for (int mt = 0; mt < 2; ++mt)
#pragma unroll
                for (int r = 0; r < 16; r += 2) tm = fmaxf(fmaxf(st[mt][r], st[mt][r + 1]), tm);
            tm = max_xor32(tm);
            const bool need = first || (tm > 8.f);
            if (__any(need)) {
                const float dm = need ? tm : 0.f;
                const float alpha = __builtin_amdgcn_exp2f(-dm);
                m_base += dm; l_run *= alpha;
#pragma unroll
                for (int mt = 0; mt < 2; ++mt)
#pragma unroll
                    for (int r = 0; r < 16; ++r) st[mt][r] -= dm;
#pragma unroll
                for (int mo = 0; mo < 4; ++mo)
#pragma unroll
                    for (int r = 0; r < 16; ++r) o[mo][r] *= alpha;
            }
            first = false;
            ps_acc = 0.f;
            if (j == 0) do_pv(bo_cur);
            else { exp_chunk(0); exp_chunk(1); exp_chunk(2); exp_chunk(3); pending = true; }
            l_run += ps_acc;
        }
        asm volatile("s_waitcnt vmcnt(0)" ::: "memory");
        __syncthreads();
        { const int t_ = bo_prv; bo_prv = bo_cur; bo_cur = bo_nxt; bo_nxt = t_; }
    }
    if (j == 1 && pending) do_pv_plain(bo_prv);
#undef AT_DMA
    const float l_tot = sum_xor32(l_run);
    float inv = 1.f / l_tot; if (j == 1) inv *= lam;
    __attribute__((address_space(3))) float* ex = (__attribute__((address_space(3))) float*)lds;
    __syncthreads();
    if (j == 1) {
#pragma unroll
        for (int mo = 0; mo < 4; ++mo)
#pragma unroll
            for (int r = 0; r < 16; ++r) ex[(w * 64 + mo * 16 + r) * 64 + lane] = o[mo][r] * inv;
    }
    __syncthreads();
    if (j == 0) {
        float sq = 0.f;
#pragma unroll
        for (int mo = 0; mo < 4; ++mo)
#pragma unroll
            for (int r = 0; r < 16; ++r) { const float v = o[mo][r] * inv - ex[(w * 64 + mo * 16 + r) * 64 + lane]; o[mo][r] = v; sq += v * v; }
        sq = sum_xor32(sq);
        const float rn = rsqrtf(sq * (1.f / 128.f) + 1e-5f) * oscale;
        const bf16_t* rowp = big + (rowbase + q0 + 32 * w + l32) * 4096 + h * 128;
        bf16_t* orow = osp + (rowbase + q0 + 32 * w + l32) * 1024 + h * 128;
#pragma unroll
        for (int mo = 0; mo < 4; ++mo)
#pragma unroll
            for (int rq = 0; rq < 4; ++rq) { const int dv = 32 * mo + 8 * rq + 4 * hf;
                const u32x2 gw = *(const u32x2*)(rowp + 3072 + dv); const f32x4 sg = *(const f32x4*)(subln_g + dv);
                f32x4 v;
                v[0] = o[mo][4 * rq + 0] * rn * sg[0] * siluf_(bflo(gw.x)); v[1] = o[mo][4 * rq + 1] * rn * sg[1] * siluf_(bfhi(gw.x));
                v[2] = o[mo][4 * rq + 2] * rn * sg[2] * siluf_(bflo(gw.y)); v[3] = o[mo][4 * rq + 3] * rn * sg[3] * siluf_(bfhi(gw.y));
                st_bf4(orow + dv, v); }
    }
}

DI void sgu_unit(bf16_t* z, int chunk, int g, const bf16_t* wsb, const float* bs, const float* lng, const float* lnb, const float* vst, char* lds_generic) {
    lds_uc* lds = (lds_uc*)lds_generic;
    const int tid = otid(), wid = __builtin_amdgcn_readfirstlane(tid >> 6), lane = tid & 63, tt = wid & 3, dh = wid >> 2, hf = lane >> 5, l32 = lane & 31;
    const int t0 = chunk * 128;
    __attribute__((address_space(3))) float* stt = (__attribute__((address_space(3))) float*)(lds + 72 * 1024);
    const int ch = tid & 31, r0 = tid >> 5;
    bf16_t* tile = z + (size_t)(t0 + r0) * 6144 + g * 256 + ch * 8;
    u32x4 raw[8];
#pragma unroll
    for (int i = 0; i < 8; ++i) raw[i] = *(const u32x4*)(tile + (size_t)(16 * i) * 6144 + 2048);
    const int nks = 2 * (tt + 1);
    bf16x8 wf[8];
#pragma unroll
    for (int ks = 0; ks < 8; ++ks) { if (ks < nks) wf[ks] = *(const bf16x8*)(wsb + ((size_t)g * 128 + 32 * tt + l32) * 128 + 16 * ks + 8 * hf); else wf[ks] = (bf16x8){0, 0, 0, 0, 0, 0, 0, 0}; }
    float gq[8], bq[8];
    { const f32x4 a = *(const f32x4*)(lng + g * 256 + ch * 8), b = *(const f32x4*)(lng + g * 256 + ch * 8 + 4), c = *(const f32x4*)(lnb + g * 256 + ch * 8), d = *(const f32x4*)(lnb + g * 256 + ch * 8 + 4);
#pragma unroll
      for (int i = 0; i < 4; ++i) { gq[i] = a[i]; gq[4 + i] = b[i]; bq[i] = c[i]; bq[4 + i] = d[i]; } }
    const float bsv = bs[g * 128 + 32 * tt + l32];
    __syncthreads();
    if (tid < 128) { const f32x4* pv = (const f32x4*)(vst + (size_t)(t0 + tid) * 64); float s1 = 0.f, s2 = 0.f;
#pragma unroll
        for (int i = 0; i < 16; ++i) { const f32x4 q4 = pv[i]; s1 += q4[0] + q4[2]; s2 += q4[1] + q4[3]; }
        const float mu = s1 * (1.f / 2048.f), var = s2 * (1.f / 2048.f) - mu * mu;
        stt[2 * tid] = mu; stt[2 * tid + 1] = rsqrtf(fmaxf(var, 0.f) + 1e-5f); }
    __syncthreads();
#pragma unroll
    for (int i = 0; i < 8; ++i) { const int row = r0 + 16 * i;
        const float mu = stt[2 * row], rstd = stt[2 * row + 1];
        float f[8]; f[0] = bflo(raw[i].x); f[1] = bfhi(raw[i].x); f[2] = bflo(raw[i].y); f[3] = bfhi(raw[i].y); f[4] = bflo(raw[i].z); f[5] = bfhi(raw[i].z); f[6] = bflo(raw[i].w); f[7] = bfhi(raw[i].w);
#pragma unroll
        for (int e = 0; e < 8; ++e) f[e] = (f[e] - mu) * rstd * gq[e] + bq[e];
        u32x4 w4; w4.x = pk2(f[0], f[1]); w4.y = pk2(f[2], f[3]); w4.z = pk2(f[4], f[5]); w4.w = pk2(f[6], f[7]);
        *(__attribute__((address_space(3))) u32x4*)(lds + row * 512 + ((ch ^ fxr(row)) << 4)) = w4; }
    __syncthreads();
    u32x4 uq[8], gt[8];
#pragma unroll
    for (int i = 0; i < 8; ++i) { uq[i] = *(const u32x4*)(tile + (size_t)(16 * i) * 6144); gt[i] = *(const u32x4*)(tile + (size_t)(16 * i) * 6144 + 4096); }
    f32x16 acc[4];
#pragma unroll
    for (int mo = 0; mo < 4; ++mo)
#pragma unroll
        for (int r = 0; r < 16; ++r) acc[mo][r] = 0.f;
    const int g_blk = (lane >> 4) & 1, g_q = (lane & 15) >> 2, g_p = lane & 3;
    auto ld_frag = [&](int ks, bf16x8 (&vf)[4]) {
#pragma unroll
        for (int mo = 0; mo < 4; ++mo) {
            const int row0 = 16 * ks + 8 * hf + g_q, row1 = row0 + 4, chx = 4 * (dh * 4 + mo) + 2 * g_blk + (g_p >> 1);
            const s16x4 lo = __builtin_amdgcn_ds_read_tr16_b64_v4i16((__attribute__((address_space(3))) s16x4*)(lds + row0 * 512 + ((chx ^ fxr(row0)) << 4) + 8 * (g_p & 1)));
            const s16x4 hi = __builtin_amdgcn_ds_read_tr16_b64_v4i16((__attribute__((address_space(3))) s16x4*)(lds + row1 * 512 + ((chx ^ fxr(row1)) << 4) + 8 * (g_p & 1)));
            vf[mo] = (bf16x8){lo[0], lo[1], lo[2], lo[3], hi[0], hi[1], hi[2], hi[3]};
        }
    };
    bf16x8 va[4], vb[4];
    ld_frag(0, va);
#pragma unroll
    for (int ks = 0; ks < 8; ks += 2) {
        if (ks < nks) {
            ld_frag(ks + 1, vb);
#pragma unroll
            for (int mo = 0; mo < 4; ++mo) acc[mo] = __builtin_amdgcn_mfma_f32_32x32x16_bf16(va[mo], wf[ks], acc[mo], 0, 0, 0);
            if (ks + 2 < nks) ld_frag(ks + 2, va);
#pragma unroll
            for (int mo = 0; mo < 4; ++mo) acc[mo] = __builtin_amdgcn_mfma_f32_32x32x16_bf16(vb[mo], wf[ks + 1], acc[mo], 0, 0, 0);
        }
    }
    __syncthreads();
#pragma unroll
    for (int mo = 0; mo < 4; ++mo)
#pragma unroll
        for (int rq = 0; rq < 4; ++rq) { const int d = (dh * 4 + mo) * 32 + 8 * rq + 4 * hf; u32x2 w2;
            w2.x = pk2(acc[mo][4 * rq + 0] + bsv, acc[mo][4 * rq + 1] + bsv); w2.y = pk2(acc[mo][4 * rq + 2] + bsv, acc[mo][4 * rq + 3] + bsv);
            *(__attribute__((address_space(3))) u32x2*)(lds + (32 * tt + l32) * 520 + d * 2) = w2; }
    __syncthreads();
#pragma unroll
    for (int i = 0; i < 8; ++i) { const int row = r0 + 16 * i;
        const u32x2 m0 = *(const __attribute__((address_space(3))) u32x2*)(lds + row * 520 + ch * 16), m1 = *(const __attribute__((address_space(3))) u32x2*)(lds + row * 520 + ch * 16 + 8);
        const u32x4 u4 = uq[i], g4 = gt[i]; u32x4 y;
        y.x = pk2(bflo(u4.x) * bflo(m0.x) * siluf_(bflo(g4.x)), bfhi(u4.x) * bfhi(m0.x) * siluf_(bfhi(g4.x)));
        y.y = pk2(bflo(u4.y) * bflo(m0.y) * siluf_(bflo(g4.y)), bfhi(u4.y) * bfhi(m0.y) * siluf_(bfhi(g4.y)));
        y.z = pk2(bflo(u4.z) * bflo(m1.x) * siluf_(bflo(g4.z)), bfhi(u4.z) * bfhi(m1.x) * siluf_(bfhi(g4.z)));
        y.w = pk2(bflo(u4.w) * bflo(m1.y) * siluf_(bflo(g4.w)), bfhi(u4.w) * bfhi(m1.y) * siluf_(bfhi(g4.w)));
        *(u32x4*)(tile + (size_t)(16 * i) * 6144) = y; }
}

DI float wave_sum(float v) {
#pragma unroll
    for (int o = 32; o > 0; o >>= 1) v += __shfl_xor(v, o);
    return v;
}

#define XB_TMO      128
#define XB_XCNT(j)  (256  + 64 * (j))
#define XB_XSUB(j)  (1280 + 64 * (j))
#define XB_XGEN(j)  (2304 + 64 * (j))
#define XB_TOP      3328
#define XB_TOPGEN   3392
#define XCD_BAR_WORDS 3456
#define XB_SPIN_CAP (1u << 18)
#define LAS __attribute__((address_space(3)))
DI unsigned xb_ld(unsigned* p)              { return __hip_atomic_load(p, __ATOMIC_RELAXED, __HIP_MEMORY_SCOPE_AGENT); }
DI unsigned xb_add(unsigned* p, unsigned v) { return __hip_atomic_fetch_add(p, v, __ATOMIC_RELAXED, __HIP_MEMORY_SCOPE_AGENT); }
DI unsigned xb_xcc_id() { return (unsigned)__builtin_amdgcn_s_getreg((3 << 11) | 20) & 0xFu; }
#define XB_SPIN(cond, bar) do { unsigned _sp = 0; while (cond) { __builtin_amdgcn_s_sleep(1); \
    if ((++_sp & 255u) == 0u) { if (xb_ld(&(bar)[XB_TMO])) break; if (_sp > XB_SPIN_CAP) { atomicAdd(&(bar)[XB_TMO], 1u); break; } } } } while (0)
struct XcdBarrier { unsigned* bar; unsigned x; volatile LAS unsigned* st; };
DI XcdBarrier xcd_barrier_post(unsigned* bar, volatile LAS unsigned* st) {
    XcdBarrier b; b.bar = bar; b.x = xb_xcc_id(); b.st = st;
    if (threadIdx.x == 0) (void)xb_add(&bar[XB_XCNT(b.x)], 1u);
    return b;
}
DI void xcd_barrier_complete(unsigned* bar, unsigned x, unsigned& nloc, unsigned& nx) {
    const unsigned G = gridDim.x * gridDim.y * gridDim.z;
    unsigned sum, cnt, mine, sp = 0u;
    for (;;) {
        sum = 0u; cnt = 0u; mine = 0u;
#pragma unroll
        for (unsigned j = 0; j < 16; ++j) { const unsigned c = xb_ld(&bar[XB_XCNT(j)]); sum += c; cnt += (c > 0u) ? 1u : 0u; mine = (j == x) ? c : mine; }
        if (sum == G) break;
        __builtin_amdgcn_s_sleep(1);
        if ((++sp & 255u) == 0u) { if (xb_ld(&bar[XB_TMO])) break; if (sp > XB_SPIN_CAP) { atomicAdd(&bar[XB_TMO], 1u); break; } }
    }
    nloc = mine > 0u ? mine : 1u; nx = cnt > 0u ? cnt : 1u;
}
template <class Work>
DI void xcd_barrier(const XcdBarrier& b, const Work& side_work) {
    asm volatile("s_waitcnt vmcnt(0)" ::: "memory");
    __syncthreads();
    if (threadIdx.x >= 64) side_work((int)threadIdx.x - 64);
    if (threadIdx.x == 0) {
        unsigned* bar = b.bar;
        __builtin_amdgcn_s_waitcnt(0);
        unsigned nloc = b.st[0], nx = b.st[1];
        if (nloc == 0u) { xcd_barrier_complete(bar, b.x, nloc, nx); b.st[0] = nloc; b.st[1] = nx; }
        const unsigned old = xb_add(&bar[XB_XSUB(b.x)], 1u);
        const unsigned gen = old / nloc;
        if (old + 1u == (gen + 1u) * nloc) {
            __builtin_amdgcn_fence(__ATOMIC_RELEASE, "agent");
            asm volatile("s_waitcnt vmcnt(0)" ::: "memory");
            const unsigned og = xb_add(&bar[XB_TOP], 1u);
            const unsigned tg = og / nx;
            if (og + 1u == (tg + 1u) * nx) xb_add(&bar[XB_TOPGEN], 1u);
            else XB_SPIN(xb_ld(&bar[XB_TOPGEN]) == tg, bar);
            __builtin_amdgcn_fence(__ATOMIC_ACQUIRE, "agent");
            xb_add(&bar[XB_XGEN(b.x)], 1u);
            asm volatile("s_waitcnt vmcnt(0)" ::: "memory");
        } else {
            XB_SPIN(xb_ld(&bar[XB_XGEN(b.x)]) == gen, bar);
            __builtin_amdgcn_fence(__ATOMIC_ACQUIRE, "agent");
            asm volatile("s_waitcnt vmcnt(0)" ::: "memory");
        }
    }
    __syncthreads();
}

typedef const __attribute__((address_space(4))) Params* kparams_t;
#define KP kparams_t pp = (kparams_t)__builtin_amdgcn_kernarg_segment_ptr(); asm volatile("" : "+s"(pp)); char* ws = pp->ws; (void)ws;
#define W_XB ((bf16_t*)(ws + OFF_XB))
#define W_BIG ((bf16_t*)(ws + OFF_BIG))
#define W_OSP ((bf16_t*)(ws + OFF_BIG + 256 * MiB))
#define W_WIN ((bf16_t*)(ws + OFF_WIN))
#define W_WOA ((bf16_t*)(ws + OFF_WOA))
#define W_WOS ((bf16_t*)(ws + OFF_WOS))
#define W_WP ((bf16_t*)(ws + OFF_WP))
#define W_WG ((bf16_t*)(ws + OFF_WG))
#define W_PB ((bf16_t*)(ws + OFF_PB))
#define W_SS ((float*)(ws + OFF_SS))
#define W_VST ((float*)(ws + OFF_VST))
#define W_WSB ((bf16_t*)(ws + OFF_WSB))

__global__ __launch_bounds__(512) void mega_fwd(Params P_unused) {
    extern __shared__ __attribute__((aligned(16))) char lds[];
    cg::grid_group grid = cg::this_grid();
    const int G = gridDim.x;
    __shared__ uint4 xb_words;
    if (threadIdx.x == 0) xb_words = make_uint4(0u, 0u, 0u, 0u);
    {
        PH_BEGIN(0)
        KP
        if (blockIdx.x == 0) { unsigned* bar = (unsigned*)(ws + OFF_BAR); for (int i = threadIdx.x; i < XCD_BAR_WORDS; i += 512) bar[i] = 0u; }
        {
            const int tx = otid();
            constexpr int I_WO = 1024 * 32, I_SO = 1024 * 64, I_PP = 1024 * 8, I_PG = 1024 * 32, I_WI = 4096 * 32;
            constexpr int total = 2 * I_WO + 2 * I_SO + 4 * I_PP + 4 * I_PG + I_WI;
            for (int it = blockIdx.x * 512 + tx; it < total; it += G * 512) {
                int r = it;
                if (r < 2 * I_WO) { const int j = r / I_WO; conv_item(pp->attn_w_out + (size_t)j * 1024 * 1024, 1024, 1024, W_WOA + (size_t)j * 1024 * 1024, nullptr, 0, 1.f, r % I_WO); continue; }
                r -= 2 * I_WO;
                if (r < 2 * I_SO) { const int j = r / I_SO; conv_item(pp->sgu_w_out + (size_t)j * 2048 * 1024, 2048, 1024, W_WOS + (size_t)j * 1024 * 2048, nullptr, 0, 1.f, r % I_SO); continue; }
                r -= 2 * I_SO;
                if (r < 4 * I_PP) { const int j = r / I_PP; conv_item(pp->ple_proj + (size_t)j * 256 * 1024, 256, 1024, W_WP + (size_t)j * 1024 * 256, nullptr, 0, 1.f, r % I_PP); continue; }
                r -= 4 * I_PP;
                if (r < 4 * I_PG) { const int j = r / I_PG; conv_item(pp->ple_gate + (size_t)j * 1024 * 1024, 1024, 1024, W_WG + (size_t)j * 1024 * 1024, nullptr, 0, 1.f, r % I_PG); continue; }
                r -= 4 * I_PG;
                conv_item(pp->attn_w_in, 1024, 4096, W_WIN, pp->attn_norm, 1024, 0.125f * LOG2E, r);
            }
        }
        { const int tid = otid(); const float* wsrc = pp->w_s; bf16_t* wdst = W_WSB;
          for (size_t e = (size_t)blockIdx.x * 512 + tid; e < (size_t)2 * 8 * 128 * 128; e += (size_t)G * 512) {
              const int s = (int)(e & 127), t = (int)((e >> 7) & 127);
              wdst[e] = (s <= t) ? f2bf(wsrc[e]) : (bf16_t)0; } }
        { const int tid = otid(), wid = tid >> 6, lane = tid & 63; const float* x = pp->x; bf16_t* XB = W_XB; float* SS = W_SS;
          for (int row = blockIdx.x * 8 + wid; row < T_; row += G * 8) {
              const float* xr = x + (size_t)row * 1024; float sq = 0.f;
#pragma unroll
              for (int i = 0; i < 4; ++i) { const f32x4 v = *(const f32x4*)(xr + i * 256 + lane * 4); sq += (v[0] * v[0] + v[1] * v[1]) + (v[2] * v[2] + v[3] * v[3]);
                  st_bf4(XB + (size_t)row * 1024 + i * 256 + lane * 4, v); }
              sq = wave_sum(sq);
              if (lane < 16) SS[(size_t)row * 16 + lane] = (lane == 0) ? sq : 0.f; } }
        conv_flat(pp->p, W_PB, (size_t)T_ * 256);
        PH_END(0)
    }
    grid.sync();
    { KP (void)xcd_barrier_post((unsigned*)(ws + OFF_BAR), (volatile LAS unsigned*)&xb_words); }
#define XBAR_W(WORK) do { KP XcdBarrier xb_; xb_.bar = (unsigned*)(ws + OFF_BAR); xb_.x = xb_xcc_id(); xb_.st = (volatile LAS unsigned*)&xb_words; xcd_barrier(xb_, WORK); } while (0)
#define XBAR XBAR_W([](int) {})

#pragma unroll 1
    for (int layer = 0; layer < 4; ++layer) {
        const int jl = layer >> 1;
        if ((layer & 1) == 0) {
            { PH_BEGIN(1)
            { KP EpiQKVG epi{W_BIG, W_SS}; gemm_phase(lds, W_XB, 1024, W_WIN, 1024, 1024, T_, 4096, epi, STAGGER_TICKS); }
            PH_END(1) }
            XBAR_W([&](int lt) { if (layer > 0) conv_flat_part(pp->p + (size_t)layer * T_ * 256, W_PB, (size_t)T_ * 256, lt, 448, 1, 2); });
            for (int rep = 0; rep < PROBE_ATTN_REPS; ++rep) {
                PH_BEGIN(2)
                KP
                float lam; const int lane = otid() & 63;
                const float li = (layer == 0 ? pp->lam_init0 : pp->lam_init2);
                { const float a = pp->lq1[jl * 64 + lane] * pp->lk1[jl * 64 + lane], b2 = pp->lq2[jl * 64 + lane] * pp->lk2[jl * 64 + lane];
                  lam = __expf(wave_sum(a)) - __expf(wave_sum(b2)) + li; }
                const float oscale = 1.f - li;
                const float* sg = pp->subln + jl * 128;
                bf16_t* BIG = W_BIG; bf16_t* OSP = W_OSP;
#pragma unroll 1
                for (int pr = blockIdx.x; pr < 1024; pr += G) {
                    const int c = pr & 255, i = pr >> 8, xcd = c & 7, slot = c >> 3;
                    const int bh = i * 16 + xcd * 2 + (slot >> 4), pq = slot & 15, b = bh >> 3, h = bh & 7;
                    const float slope2 = exp2f(-(float)(h + 1)) * LOG2E;
                    attn_unit(BIG, OSP, b, h, 31 - pq, lam, slope2, sg, oscale, lds);
                    attn_unit(BIG, OSP, b, h, pq, lam, slope2, sg, oscale, lds);
                }
                PH_END(2)
            }
            XBAR_W([&](int lt) { conv_T_part(pp->sgu_w_in + (size_t)jl * 1024 * 6144, 1024, 6144, W_WIN, pp->sgu_norm + jl * 1024, 0, 1.f, lt, 448, 0, 2); });
            { PH_BEGIN(3)
            { KP EpiRes epi{W_XB, W_BIG + 2048, 4096}; gemm_phase(lds, W_OSP, 1024, W_WOA + (size_t)jl * 1024 * 1024, 1024, 1024, T_, 1024, epi); }
            { KP EpiE epi{W_BIG + 1024, 4096}; gemm_phase(lds, W_PB, 256, W_WP + (size_t)layer * 1024 * 256, 256, 256, T_, 1024, epi); }
            PH_END(3) }
            XBAR_W([&](int lt) { conv_T_part(pp->sgu_w_in + (size_t)jl * 1024 * 6144, 1024, 6144, W_WIN, pp->sgu_norm + jl * 1024, 0, 1.f, lt, 448, 1, 2); });
            { PH_BEGIN(4)
            { KP EpiGate epi{W_BIG + 2048, 4096, W_BIG + 1024, 4096, W_XB, W_SS}; gemm_phase(lds, W_BIG + 2048, 4096, W_WG + (size_t)layer * 1024 * 1024, 1024, 1024, T_, 1024, epi); }
            PH_END(4) }
            XBAR_W([&](int lt) { conv_flat_part(pp->p + (size_t)(layer + 1) * T_ * 256, W_PB, (size_t)T_ * 256, lt, 448, 0, 2); });
        } else {
            { PH_BEGIN(5)
            { KP EpiSguIn epi{W_BIG, W_SS, W_VST}; gemm_phase(lds, W_XB, 1024, W_WIN, 1024, 1024, T_, 6144, epi, STAGGER_TICKS); }
            PH_END(5) }
            XBAR_W([&](int lt) { if (layer > 0) conv_flat_part(pp->p + (size_t)layer * T_ * 256, W_PB, (size_t)T_ * 256, lt, 448, 1, 2); });
            { PH_BEGIN(6) KP
              const bf16_t* wsb = W_WSB + (size_t)jl * 8 * 128 * 128; const float* bs = pp->b_s + jl * 8 * 128; const float* lg = pp->ln_g + jl * 2048; const float* lb = pp->ln_b + jl * 2048;
              bf16_t* BIG = W_BIG; const float* VST = W_VST;
#pragma unroll 1
              for (int u = blockIdx.x; u < 2048; u += G) sgu_unit(BIG, u >> 3, u & 7, wsb, bs, lg, lb, VST, lds);
              PH_END(6) }
            XBAR_W([&](int lt) { if (layer + 1 < 4) conv_T_part(pp->attn_w_in + (size_t)(jl + 1) * 1024 * 4096, 1024, 4096, W_WIN, pp->attn_norm + (jl + 1) * 1024, 1024, 0.125f * LOG2E, lt, 448, 0, 2); });
            { PH_BEGIN(7)
            { KP EpiRes epi{W_XB, W_BIG + 4096, 6144}; gemm_phase(lds, W_BIG, 6144, W_WOS + (size_t)jl * 1024 * 2048, 2048, 2048, T_, 1024, epi); }
            { KP EpiE epi{W_BIG + 2048, 6144}; gemm_phase(lds, W_PB, 256, W_WP + (size_t)layer * 1024 * 256, 256, 256, T_, 1024, epi); }
            PH_END(7) }
            XBAR_W([&](int lt) { if (layer + 1 < 4) conv_T_part(pp->attn_w_in + (size_t)(jl + 1) * 1024 * 4096, 1024, 4096, W_WIN, pp->attn_norm + (jl + 1) * 1024, 1024, 0.125f * LOG2E, lt, 448, 1, 2); });
            { PH_BEGIN(8)
            { KP EpiGate epi{W_BIG + 4096, 6144, W_BIG + 2048, 6144, W_XB, W_SS}; gemm_phase(lds, W_BIG + 4096, 6144, W_WG + (size_t)layer * 1024 * 1024, 1024, 1024, T_, 1024, epi); }
            PH_END(8) }
            XBAR_W([&](int lt) { if (layer + 1 < 4) conv_flat_part(pp->p + (size_t)(layer + 1) * T_ * 256, W_PB, (size_t)T_ * 256, lt, 448, 0, 2); });
        }
    }
    {
        PH_BEGIN(9)
        KP
        const int tid = otid(), wid = tid >> 6, lane = tid & 63; float* OUT = pp->out; const bf16_t* XB = W_XB; const float* SS = W_SS; const float* fg = pp->final_norm;
        for (int row = blockIdx.x * 8 + wid; row < T_; row += G * 8) {
            const float rs = rs_from_ss(SS, row);
#pragma unroll
            for (int i = 0; i < 2; ++i) { const int c = i * 512 + lane * 8; const u32x4 xw = *(const u32x4*)(XB + (size_t)row * 1024 + c);
                const f32x4 g0 = *(const f32x4*)(fg + c), g1 = *(const f32x4*)(fg + c + 4);
                f32x4 o0, o1; o0[0] = bflo(xw.x) * rs * g0[0]; o0[1] = bfhi(xw.x) * rs * g0[1]; o0[2] = bflo(xw.y) * rs * g0[2]; o0[3] = bfhi(xw.y) * rs * g0[3];
                o1[0] = bflo(xw.z) * rs * g1[0]; o1[1] = bfhi(xw.z) * rs * g1[1]; o1[2] = bflo(xw.w) * rs * g1[2]; o1[3] = bfhi(xw.w) * rs * g1[3];
                *(f32x4*)(OUT + (size_t)row * 1024 + c) = o0; *(f32x4*)(OUT + (size_t)row * 1024 + c + 4) = o1; }
        }
        PH_END(9)
    }
}

extern "C" void kernel_launch(void* const* d_in, const int* in_sizes, int n_in, void* d_out, int out_size, void* d_ws, size_t ws_size, hipStream_t stream) {
    static int grid_blocks = 0;
    if (!grid_blocks) {
        int dev = 0, cus = 0, per_cu = 0;
        hipGetDevice(&dev);
        hipDeviceGetAttribute(&cus, hipDeviceAttributeMultiprocessorCount, dev);
        hipFuncSetAttribute((const void*)mega_fwd, hipFuncAttributeMaxDynamicSharedMemorySize, LDS_BYTES);
        hipOccupancyMaxActiveBlocksPerMultiprocessor(&per_cu, mega_fwd, 512, LDS_BYTES);
        if (per_cu < 1) per_cu = 1;
        grid_blocks = cus * 1;
    }
    Params P{};
    const float** pp = (const float**)&P;
    for (int i = 0; i < 20; ++i) pp[i] = (const float*)d_in[i];
    P.out = (float*)d_out; P.ws = (char*)d_ws;
    P.lam_init0 = 0.2f; P.lam_init2 = (float)(0.8 - 0.6 * 0.54881163609402643);
    void* args[] = {&P};
    hipError_t e = hipLaunchCooperativeKernel((void*)mega_fwd, dim3(grid_blocks), dim3(512), args, LDS_BYTES, stream);
    if (e != hipSuccess) fprintf(stderr, "cooperative launch failed: %s (grid %d)\n", hipGetErrorString(e), grid_blocks);
}
```

```cpp
#include <hip/hip_runtime.h>
#include <hip/hip_cooperative_groups.h>
#include <cstdio>
#include <cstdint>
namespace cg = cooperative_groups;

#define DI __device__ __forceinline__
typedef unsigned short bf16_t;
typedef short bf16x8 __attribute__((ext_vector_type(8)));
typedef short s16x4 __attribute__((ext_vector_type(4)));
typedef float f32x2 __attribute__((ext_vector_type(2)));
typedef float f32x4 __attribute__((ext_vector_type(4)));
typedef float f32x16 __attribute__((ext_vector_type(16)));
typedef __bf16 bf16x2v __attribute__((ext_vector_type(2)));
typedef unsigned u32x2 __attribute__((ext_vector_type(2)));
typedef unsigned u32x4 __attribute__((ext_vector_type(4)));

constexpr int T_ = 32768, S_ = 4096;
constexpr size_t MiB = 1024 * 1024;
constexpr size_t OFF_XB = 0, OFF_BIG = 64 * MiB, OFF_WIN = 448 * MiB, OFF_WOA = 460 * MiB, OFF_WOS = 464 * MiB, OFF_WP = 472 * MiB,
                 OFF_WG = 474 * MiB, OFF_PB = 482 * MiB, OFF_SS = 498 * MiB, OFF_VST = 500 * MiB, OFF_WSB = 508 * MiB, OFF_BAR = 509 * MiB;
constexpr int LDS_BYTES = 128 * 1024;
#define STAGGER_TICKS 0
#ifndef PROBE_MASK
#define PROBE_MASK 0
#endif
#define PH_BEGIN(id) unsigned long long _pt0 = 0; if (PROBE_MASK & (1 << (id))) _pt0 = __builtin_amdgcn_s_memrealtime();
#define PH_END(id) if (PROBE_MASK & (1 << (id))) { const unsigned long long _pt1 = __builtin_amdgcn_s_memrealtime(); while (__builtin_amdgcn_s_memrealtime() - _pt1 < _pt1 - _pt0) __builtin_amdgcn_s_sleep(8); }
#ifndef PROBE_ATTN_REPS
#define PROBE_ATTN_REPS 1
#endif
#define LOG2E 1.4426950408889634f

struct Params {
    const float *x, *p, *attn_norm, *attn_w_in, *lq1, *lk1, *lq2, *lk2, *subln, *attn_w_out, *sgu_norm, *sgu_w_in, *ln_g, *ln_b, *w_s, *b_s,
        *sgu_w_out, *ple_proj, *ple_gate, *final_norm;
    float* out;
    char* ws;
    float lam_init0, lam_init2;
};

DI int otid() { int t = threadIdx.x; asm volatile("" : "+v"(t)); return t; }
DI float sum_xor32(float v) { const u32x2 r = __builtin_amdgcn_permlane32_swap(__float_as_uint(v), __float_as_uint(v), false, false); return __uint_as_float(r[0]) + __uint_as_float(r[1]); }
DI float max_xor32(float v) { const u32x2 r = __builtin_amdgcn_permlane32_swap(__float_as_uint(v), __float_as_uint(v), false, false); return fmaxf(__uint_as_float(r[0]), __uint_as_float(r[1])); }
DI float sum_xor16(float v) { const u32x2 r = __builtin_amdgcn_permlane16_swap(__float_as_uint(v), __float_as_uint(v), false, false); return __uint_as_float(r[0]) + __uint_as_float(r[1]); }
DI unsigned pk2(float a, float b) { f32x2 v = {a, b}; return __builtin_bit_cast(unsigned, __builtin_convertvector(v, bf16x2v)); }
DI bf16_t f2bf(float a) { return (bf16_t)(pk2(a, 0.f) & 0xffffu); }
DI float bflo(unsigned u) { return __uint_as_float(u << 16); }
DI float bfhi(unsigned u) { return __uint_as_float(u & 0xffff0000u); }
DI float sigmoidf_(float x) { return __builtin_amdgcn_rcpf(1.f + __builtin_amdgcn_exp2f(-x * LOG2E)); }
DI float siluf_(float x) { return x * sigmoidf_(x); }
DI f32x2 gelu_pk(f32x2 v) {
    const f32x2 av = __builtin_elementwise_abs(v), d = av * 0.2316418882f + 1.0f;
    f32x2 t; t.x = __builtin_amdgcn_rcpf(d.x); t.y = __builtin_amdgcn_rcpf(d.y);
    f32x2 q = t * 0.5307027145f + (-0.7265760135f); q = q * t + 0.7107068705f; q = q * t + (-0.142248368f); q = q * t + 0.127414796f; q = q * t;
    const f32x2 s = (v * v) * (-0.72134752044f);
    f32x2 e; e.x = __builtin_amdgcn_exp2f(s.x); e.y = __builtin_amdgcn_exp2f(s.y);
    const f32x2 m = v * (q * e), r = v - m;
    f32x2 o; o.x = v.x < 0.f ? m.x : r.x; o.y = v.y < 0.f ? m.y : r.y; return o;
}
DI int fxr(int row) { return ((row & 3) << 2) | ((row >> 2) & 3); }

DI void conv_item(const float* src, int K, int N, bf16_t* dst, const float* gain, int nscale, float cs, int item) {
    const int n = item % N, kb = item / N;
    const float* sp = src + (size_t)(kb * 32) * N + n;
    float v[32];
#pragma unroll
    for (int i = 0; i < 32; ++i) v[i] = sp[(size_t)i * N];
    const float sc = (n < nscale) ? cs : 1.f;
    if (gain) {
#pragma unroll
        for (int i = 0; i < 32; ++i) v[i] *= gain[kb * 32 + i];
    }
    bf16_t* dp = dst + (size_t)n * K + kb * 32;
#pragma unroll
    for (int q = 0; q < 4; ++q) { u32x4 w; w.x = pk2(v[8 * q] * sc, v[8 * q + 1] * sc); w.y = pk2(v[8 * q + 2] * sc, v[8 * q + 3] * sc);
        w.z = pk2(v[8 * q + 4] * sc, v[8 * q + 5] * sc); w.w = pk2(v[8 * q + 6] * sc, v[8 * q + 7] * sc); *(u32x4*)(dp + 8 * q) = w; }
}
DI void conv_T_part(const float* src, int K, int N, bf16_t* dst, const float* gain, int nscale, float cs, int lt, int nt, int part, int nparts) {
    const int total = N * (K >> 5), lo = (int)((long)total * part / nparts), hi = (int)((long)total * (part + 1) / nparts);
    for (int item = lo + blockIdx.x * nt + lt; item < hi; item += gridDim.x * nt) conv_item(src, K, N, dst, gain, nscale, cs, item);
}
DI void conv_flat_part(const float* src, bf16_t* dst, size_t n, int lt, int nt, int part, int nparts) {
    const size_t nch = n / 8, lo = nch * part / nparts, hi = nch * (part + 1) / nparts;
    for (size_t c = lo + (size_t)blockIdx.x * nt + lt; c < hi; c += (size_t)gridDim.x * nt) {
        const f32x4 a = *(const f32x4*)(src + c * 8), b = *(const f32x4*)(src + c * 8 + 4);
        u32x4 w; w.x = pk2(a[0], a[1]); w.y = pk2(a[2], a[3]); w.z = pk2(b[0], b[1]); w.w = pk2(b[2], b[3]);
        *(u32x4*)(dst + c * 8) = w;
    }
}
DI void conv_T(const float* src, int K, int N, bf16_t* dst, const float* gain, int nscale, float cs, char*) {
    const int tx = otid();
    const int total = N * (K >> 5);
    for (int item = blockIdx.x * 512 + tx; item < total; item += gridDim.x * 512) conv_item(src, K, N, dst, gain, nscale, cs, item);
}
DI void conv_flat(const float* src, bf16_t* dst, size_t n) {
    const size_t nch = n / 8;
    const int tx = otid();
    for (size_t c = (size_t)blockIdx.x * 512 + tx; c < nch; c += (size_t)gridDim.x * 512) {
        const f32x4 a = *(const f32x4*)(src + c * 8), b = *(const f32x4*)(src + c * 8 + 4);
        u32x4 w; w.x = pk2(a[0], a[1]); w.y = pk2(a[2], a[3]); w.z = pk2(b[0], b[1]); w.w = pk2(b[2], b[3]);
        *(u32x4*)(dst + c * 8) = w;
    }
}

typedef __attribute__((address_space(3))) unsigned char lds_uc;
constexpr int HTB = 128 * 64 * 2;
DI int lds_byte(int r, int c) { const int st = (r >> 4) * 2 + (c >> 5), rr = r & 15, cc = c & 31, ob = rr * 64 + cc * 2; return st * 1024 + (ob ^ (((ob >> 9) & 1) << 5)); }
DI void stage_rc(int b, int& R, int& C) { const int st = b / 1024, sb = b % 1024, swz = sb ^ (((sb >> 9) & 1) << 5); R = (st >> 1) * 16 + swz / 64; C = (st & 1) * 32 + (swz % 64) / 2; }
#ifndef WGM_
#define WGM_ 4
#endif
struct Unit { int pm, pn; };
struct StaticOrder {
    int nM, nN, nwg, G, c;
    DI void init(int M, int N, int G_, int c_) { nM = M / 256; nN = N / 256; nwg = nM * nN; G = G_; c = c_; }
    DI bool next(int i, Unit& u) const {
        const long L = (long)i * G + c; if (L >= nwg) return false;
        int wgid = (int)L; { const int q = nwg / 8, r = nwg % 8, xcd = wgid % 8, off = wgid / 8; wgid = (xcd < r ? xcd * (q + 1) : r * (q + 1) + (xcd - r) * q) + off; }
        const int nig = WGM_ * nN, gid = wgid / nig, fm = gid * WGM_, gsz = (nM - fm) < WGM_ ? (nM - fm) : WGM_;
        u.pm = fm + ((wgid % nig) % gsz); u.pn = (wgid % nig) / gsz; return true;
    }
};

template <class Epi>
DI void gemm_phase(char* lds_generic, const bf16_t* A, int lda, const bf16_t* Bt, int ldb, int K, int M, int N, const Epi& E, int stagger_ticks = 0) {
    lds_uc* lds = (lds_uc*)lds_generic;
    const int tid = otid(), wid = __builtin_amdgcn_readfirstlane(tid >> 6), lane = tid & 63, wr = wid >> 2, wc = wid & 3, fr = lane & 15, fq = lane >> 4;
    StaticOrder S; S.init(M, N, gridDim.x, blockIdx.x);
    const int nt = K / 64;
    unsigned voffA[2], voffB[2];
#pragma unroll
    for (int i = 0; i < 2; ++i) { int R, C; stage_rc(tid * 16 + i * 8192, R, C); const int rho = R & 31, Rb = (R & ~31) + 8 * ((rho & 15) >> 2) + 4 * (rho >> 4) + (rho & 3);
        voffA[i] = (unsigned)(R * lda + C) * 2u; voffB[i] = (unsigned)(Rb * ldb + C) * 2u; }
    const size_t kstep = 128;
    const size_t hstepA = (size_t)128 * lda * 2, hstepB = (size_t)128 * ldb * 2, tstepA = 2 * hstepA, tstepB = 2 * hstepB;
    const unsigned ldsw = (unsigned)wid * 1024u;
    const int aoff = lds_byte(wr * 64 + fr, fq * 8), boff = lds_byte(wc * 32 + fr, fq * 8);
#define PG8_SA(b, h) (((b) * 2 + (h)) * HTB)
#define PG8_SB(b, h) ((4 + (b) * 2 + (h)) * HTB)
#define PG8_STAGE(bufoff, gbase, voff) do { _Pragma("unroll") for (int _i = 0; _i < 2; ++_i) \
        __builtin_amdgcn_global_load_lds((const unsigned*)((const char*)(gbase) + (voff)[_i]), (__attribute__((address_space(3))) unsigned*)(lds + (bufoff) + ldsw + _i * 8192), 16, 0, 0); } while (0)
#define PG8_LDA(dst, b, h) do { _Pragma("unroll") for (int m = 0; m < 4; ++m) _Pragma("unroll") for (int k = 0; k < 2; ++k) dst[m][k] = *(const __attribute__((address_space(3))) bf16x8*)(lds + PG8_SA(b, h) + aoff + m * 2048 + k * 1024); } while (0)
#define PG8_LDB(dst, b, h) do { _Pragma("unroll") for (int n = 0; n < 2; ++n) _Pragma("unroll") for (int k = 0; k < 2; ++k) dst[n][k] = *(const __attribute__((address_space(3))) bf16x8*)(lds + PG8_SB(b, h) + boff + n * 2048 + k * 1024); } while (0)
#define PG8_MMA(ai, bj, At, Bt_) do { __builtin_amdgcn_s_setprio(1); _Pragma("unroll") for (int m = 0; m < 4; ++m) _Pragma("unroll") for (int n = 0; n < 2; ++n) _Pragma("unroll") for (int k = 0; k < 2; ++k) \
        acc[ai][bj][m][n] = __builtin_amdgcn_mfma_f32_16x16x32_bf16(Bt_[n][k], At[m][k], acc[ai][bj][m][n], 0, 0, 0); __builtin_amdgcn_s_setprio(0); } while (0)
#define PG8_WAIT_V(n) asm volatile("s_waitcnt vmcnt(" #n ")" ::: "memory")
#define PG8_WAIT_L(n) asm volatile("s_waitcnt lgkmcnt(" #n ")" ::: "memory")
#define PG8_BAR __builtin_amdgcn_s_barrier()
#define PG8_SCHED __builtin_amdgcn_sched_barrier(0)
    Unit cur, nxt; int ui = 0;
    __syncthreads();
    if (!S.next(0, cur)) return;
    PG8_WAIT_V(0);
    if (stagger_ticks) {
        const unsigned long long t0 = __builtin_amdgcn_s_memrealtime(), dl = (unsigned long long)(((blockIdx.x >> 3) & 3) * stagger_ticks);
        while (__builtin_amdgcn_s_memrealtime() - t0 < dl) __builtin_amdgcn_s_sleep(8);
    }
    f32x4 acc[2][2][4][2];
#pragma unroll
    for (int a = 0; a < 2; ++a)
#pragma unroll
        for (int b = 0; b < 2; ++b)
#pragma unroll
            for (int m = 0; m < 4; ++m)
#pragma unroll
                for (int n = 0; n < 2; ++n) acc[a][b][m][n] = (f32x4){0.f, 0.f, 0.f, 0.f};
    bf16x8 At[4][2], B0[2][2], B1[2][2];
    const char* cA = (const char*)A + (size_t)cur.pm * tstepA; const char* cB = (const char*)Bt + (size_t)cur.pn * tstepB;
    PG8_STAGE(PG8_SB(0, 0), cB, voffB); PG8_STAGE(PG8_SB(0, 1), cB + hstepB, voffB); PG8_STAGE(PG8_SA(0, 0), cA, voffA); PG8_STAGE(PG8_SA(0, 1), cA + hstepA, voffA);
    if (wr == 1) PG8_BAR;
    PG8_WAIT_V(2); PG8_BAR;
    PG8_STAGE(PG8_SB(1, 0), cB + kstep, voffB); PG8_STAGE(PG8_SA(1, 0), cA + kstep, voffA); PG8_STAGE(PG8_SB(1, 1), cB + hstepB + kstep, voffB);
    PG8_WAIT_V(6); PG8_BAR;
    for (;;) {
        const bool has_next = S.next(ui + 1, nxt);
        const char* nA = has_next ? (const char*)A + (size_t)nxt.pm * tstepA : cA; const char* nB = has_next ? (const char*)Bt + (size_t)nxt.pn * tstepB : cB;
#pragma unroll 1
        for (int t = 0; t < nt; t += 2) {
            const bool last = (t == nt - 2);
            const char* a1 = cA + (size_t)(t + 1) * kstep;
            const char* a2 = last ? nA : cA + (size_t)(t + 2) * kstep; const char* b2 = last ? nB : cB + (size_t)(t + 2) * kstep;
            const char* a3 = a2 + kstep; const char* b3 = b2 + kstep;
            PG8_LDB(B0, 0, 0); PG8_LDB(B1, 0, 1); PG8_SCHED; PG8_LDA(At, 0, 0); PG8_STAGE(PG8_SA(1, 1), a1 + hstepA, voffA);
            PG8_WAIT_V(8); PG8_WAIT_L(0); PG8_BAR; PG8_MMA(0, 0, At, B0); PG8_MMA(0, 1, At, B1); PG8_BAR; PG8_SCHED;
            PG8_LDA(At, 0, 1); PG8_STAGE(PG8_SB(0, 0), b2, voffB); PG8_STAGE(PG8_SB(0, 1), b2 + hstepB, voffB); PG8_STAGE(PG8_SA(0, 0), a2, voffA);
            PG8_WAIT_V(8); PG8_WAIT_L(0); PG8_BAR; PG8_MMA(1, 0, At, B0); PG8_MMA(1, 1, At, B1); PG8_BAR; PG8_SCHED;
            PG8_LDB(B0, 1, 0); PG8_LDB(B1, 1, 1); PG8_SCHED; PG8_LDA(At, 1, 0); PG8_STAGE(PG8_SA(0, 1), a2 + hstepA, voffA);
            PG8_WAIT_V(8); PG8_WAIT_L(0); PG8_BAR; PG8_MMA(0, 0, At, B0); PG8_MMA(0, 1, At, B1); PG8_BAR; PG8_SCHED;
            PG8_LDA(At, 1, 1); PG8_STAGE(PG8_SB(1, 0), b3, voffB); PG8_STAGE(PG8_SB(1, 1), b3 + hstepB, voffB); PG8_STAGE(PG8_SA(1, 0), a3, voffA);
            PG8_WAIT_V(8); PG8_WAIT_L(0); PG8_BAR; PG8_MMA(1, 0, At, B0); PG8_MMA(1, 1, At, B1); PG8_BAR; PG8_SCHED;
        }
        if (wr == 0) PG8_BAR;
        E(acc, cur.pm, cur.pn, wr, wc, fr, fq);
        if (!has_next) break;
#pragma unroll
        for (int a = 0; a < 2; ++a)
#pragma unroll
            for (int b = 0; b < 2; ++b)
#pragma unroll
                for (int m = 0; m < 4; ++m)
#pragma unroll
                    for (int n = 0; n < 2; ++n) acc[a][b][m][n] = (f32x4){0.f, 0.f, 0.f, 0.f};
        cur = nxt; cA = nA; cB = nB; ++ui;
        if (wr == 1) PG8_BAR;
    }
    PG8_WAIT_V(0);
    PG8_BAR;
}

#define EPI_ARGS const f32x4 (&acc)[2][2][4][2], int pm, int pn, int wr, int wc, int fr, int fq
#define ROW_OF(ai, m) (pm * 256 + (ai) * 128 + wr * 64 + (m) * 16 + fr)
#define COL_OF(bj) (pn * 256 + (bj) * 128 + wc * 32 + fq * 8)
DI float quad_sum(float v) { return sum_xor32(sum_xor16(v)); }
DI float rs_from_ss(const float* ss, int row) {
    const f32x4* p = (const f32x4*)(ss + (size_t)row * 16); const f32x4 s = (p[0] + p[1]) + (p[2] + p[3]);
    return rsqrtf(((s[0] + s[1]) + (s[2] + s[3])) * (1.f / 1024.f) + 1e-6f); }
DI float rs_from_ss_q(const float* ss, int row, int fq) {
    const f32x4 s = *(const f32x4*)(ss + (size_t)row * 16 + fq * 4);
    return rsqrtf(quad_sum((s[0] + s[1]) + (s[2] + s[3])) * (1.f / 1024.f) + 1e-6f); }
DI void st_bf4(bf16_t* p, f32x4 v) { u32x2 w; w.x = pk2(v[0], v[1]); w.y = pk2(v[2], v[3]); *(u32x2*)p = w; }
DI void st_bf8(bf16_t* p, f32x4 a, f32x4 b) { u32x4 w; w.x = pk2(a[0], a[1]); w.y = pk2(a[2], a[3]); w.z = pk2(b[0], b[1]); w.w = pk2(b[2], b[3]); *(u32x4*)p = w; }
DI void ld_bf8(const bf16_t* p, f32x4& a, f32x4& b) { const u32x4 w = *(const u32x4*)p; a[0] = bflo(w.x); a[1] = bfhi(w.x); a[2] = bflo(w.y); a[3] = bfhi(w.y); b[0] = bflo(w.z); b[1] = bfhi(w.z); b[2] = bflo(w.w); b[3] = bfhi(w.w); }
DI float sum4(f32x4 v) { return (v[0] + v[1]) + (v[2] + v[3]); }
DI float sumsq4(f32x4 v) { return (v[0] * v[0] + v[1] * v[1]) + (v[2] * v[2] + v[3] * v[3]); }
DI f32x4 gelu4(f32x4 v) { const f32x2 a = gelu_pk((f32x2){v[0], v[1]}), b = gelu_pk((f32x2){v[2], v[3]}); return (f32x4){a.x, a.y, b.x, b.y}; }
DI f32x4 sig4(f32x4 g) { return (f32x4){sigmoidf_(g[0]), sigmoidf_(g[1]), sigmoidf_(g[2]), sigmoidf_(g[3])}; }

struct EpiQKVG {
    bf16_t* out; const float* ss;
    DI void operator()(EPI_ARGS) const {
#pragma unroll
        for (int ai = 0; ai < 2; ++ai)
#pragma unroll
            for (int m = 0; m < 4; ++m) { const int row = ROW_OF(ai, m); const float rs = rs_from_ss_q(ss, row, fq);
#pragma unroll
                for (int bj = 0; bj < 2; ++bj) st_bf8(out + (size_t)row * 4096 + COL_OF(bj), acc[ai][bj][m][0] * rs, acc[ai][bj][m][1] * rs); }
    }
};
struct EpiSguIn {
    bf16_t* z; const float* ss; float* vst;
    DI void operator()(EPI_ARGS) const {
        const bool do_gelu = pn < 16, do_stats = (pn >= 8) && (pn < 16);
#pragma unroll
        for (int ai = 0; ai < 2; ++ai)
#pragma unroll
            for (int m = 0; m < 4; ++m) { const int row = ROW_OF(ai, m); const float rs = rs_from_ss_q(ss, row, fq); float s1 = 0.f, s2 = 0.f;
#pragma unroll
                for (int bj = 0; bj < 2; ++bj) { f32x4 v0 = acc[ai][bj][m][0] * rs, v1 = acc[ai][bj][m][1] * rs;
                    if (do_gelu) { v0 = gelu4(v0); v1 = gelu4(v1); }
                    s1 += sum4(v0) + sum4(v1); s2 += sumsq4(v0) + sumsq4(v1);
                    st_bf8(z + (size_t)row * 6144 + COL_OF(bj), v0, v1); }
                if (do_stats) { s1 = quad_sum(s1); s2 = quad_sum(s2);
                    if (fq == 0) *(f32x2*)(vst + ((size_t)row * 32 + (pn - 8) * 4 + wc) * 2) = (f32x2){s1, s2}; } }
    }
};
struct EpiRes {
    const bf16_t* xin; bf16_t* xb; int ldxb;
    DI void operator()(EPI_ARGS) const {
#pragma unroll
        for (int ai = 0; ai < 2; ++ai)
#pragma unroll
            for (int m = 0; m < 4; ++m) { const int row = ROW_OF(ai, m);
#pragma unroll
                for (int bj = 0; bj < 2; ++bj) { const int col = COL_OF(bj); f32x4 x0, x1; ld_bf8(xin + (size_t)row * 1024 + col, x0, x1);
                    st_bf8(xb + (size_t)row * ldxb + col, x0 + acc[ai][bj][m][0], x1 + acc[ai][bj][m][1]); } }
    }
};
struct EpiE {
    bf16_t* e; int lde;
    DI void operator()(EPI_ARGS) const {
#pragma unroll
        for (int ai = 0; ai < 2; ++ai)
#pragma unroll
            for (int m = 0; m < 4; ++m) { const int row = ROW_OF(ai, m);
#pragma unroll
                for (int bj = 0; bj < 2; ++bj) st_bf8(e + (size_t)row * lde + COL_OF(bj), acc[ai][bj][m][0], acc[ai][bj][m][1]); }
    }
};
struct EpiGate {
    const bf16_t* xm; int ldm; const bf16_t* e; int lde; bf16_t* xb; float* ss;
    DI void operator()(EPI_ARGS) const {
#pragma unroll
        for (int ai = 0; ai < 2; ++ai)
#pragma unroll
            for (int m = 0; m < 4; ++m) { const int row = ROW_OF(ai, m); float s2 = 0.f;
#pragma unroll
                for (int bj = 0; bj < 2; ++bj) { const int col = COL_OF(bj); f32x4 x0, x1, e0, e1;
                    ld_bf8(xm + (size_t)row * ldm + col, x0, x1); ld_bf8(e + (size_t)row * lde + col, e0, e1);
                    const f32x4 v0 = x0 + e0 * sig4(acc[ai][bj][m][0]), v1 = x1 + e1 * sig4(acc[ai][bj][m][1]);
                    s2 += sumsq4(v0) + sumsq4(v1);
                    st_bf8(xb + (size_t)row * 1024 + col, v0, v1); }
                s2 = quad_sum(s2);
                if (fq == 0) ss[(size_t)row * 16 + pn * 4 + wc] = s2; }
    }
};

template <int OFF> DI void tr8_issue_off(s16x4 (&lo)[4], s16x4 (&hi)[4], const unsigned (&a)[8]) {
    asm volatile("ds_read_b64_tr_b16 %0, %8 offset:%16\n\tds_read_b64_tr_b16 %1, %9 offset:%16\n\tds_read_b64_tr_b16 %2, %10 offset:%16\n\tds_read_b64_tr_b16 %3, %11 offset:%16\n\t"
                 "ds_read_b64_tr_b16 %4, %12 offset:%16\n\tds_read_b64_tr_b16 %5, %13 offset:%16\n\tds_read_b64_tr_b16 %6, %14 offset:%16\n\tds_read_b64_tr_b16 %7, %15 offset:%16"
                 : "=&v"(lo[0]), "=&v"(hi[0]), "=&v"(lo[1]), "=&v"(hi[1]), "=&v"(lo[2]), "=&v"(hi[2]), "=&v"(lo[3]), "=&v"(hi[3])
                 : "v"(a[0]), "v"(a[1]), "v"(a[2]), "v"(a[3]), "v"(a[4]), "v"(a[5]), "v"(a[6]), "v"(a[7]), "i"(OFF) : "memory");
}
template <int N> DI void tr8_wait(s16x4 (&lo)[4], s16x4 (&hi)[4]) {
    if (N == 0) asm volatile("s_waitcnt lgkmcnt(0)" : "+v"(lo[0]), "+v"(hi[0]), "+v"(lo[1]), "+v"(hi[1]), "+v"(lo[2]), "+v"(hi[2]), "+v"(lo[3]), "+v"(hi[3]) :: "memory");
    else asm volatile("s_waitcnt lgkmcnt(8)" : "+v"(lo[0]), "+v"(hi[0]), "+v"(lo[1]), "+v"(hi[1]), "+v"(lo[2]), "+v"(hi[2]), "+v"(lo[3]), "+v"(hi[3]) :: "memory");
}
DI bf16x8 cat8(s16x4 lo, s16x4 hi) { return (bf16x8){lo[0], lo[1], lo[2], lo[3], hi[0], hi[1], hi[2], hi[3]}; }

DI void attn_unit(const bf16_t* big, bf16_t* osp, int b, int h, int qb, float lam, float slope2, const float* subln_g, float oscale, char* lds_generic) {
    lds_uc* lds = (lds_uc*)lds_generic;
    const int tid = otid(), wid = __builtin_amdgcn_readfirstlane(tid >> 6), lane = tid & 63, w = wid & 3, j = wid >> 2, hf = lane >> 5, l32 = lane & 31;
    const int q0 = qb * 128;
    const size_t rowbase = (size_t)b * S_;
    const float NEG_INF = -__builtin_inff();
    bf16x8 qf[4];
    { const bf16_t* Qp = big + (rowbase + q0 + 32 * w + l32) * 4096 + h * 128 + j * 64;
#pragma unroll
      for (int ks = 0; ks < 4; ++ks) qf[ks] = *(const bf16x8*)(Qp + 16 * ks + 8 * hf); }
    f32x16 o[4];
#pragma unroll
    for (int mo = 0; mo < 4; ++mo)
#pragma unroll
        for (int r = 0; r < 16; ++r) o[mo][r] = 0.f;
    float l_run = 0.f;
    const int nkt = 2 * qb + 2;
    const bf16_t* srcK; const bf16_t* srcV0; const bf16_t* srcV1;
    { const int row = tid >> 3, cp = tid & 7; srcK = big + (rowbase + row) * 4096 + 1024 + h * 128 + ((cp ^ ((row >> 1) & 7)) << 3); }
    { const int s0 = tid, row = s0 >> 4, cp = s0 & 15; srcV0 = big + (rowbase + row) * 4096 + 2048 + h * 128 + ((cp ^ fxr(row)) << 3); }
    { const int s1 = tid + 512, row = s1 >> 4, cp = s1 & 15; srcV1 = big + (rowbase + row) * 4096 + 2048 + h * 128 + ((cp ^ fxr(row)) << 3); }
    const unsigned ldsw = (unsigned)wid * 1024u;
#define AT_DMA(kt_, bo_) do { const size_t _ko = (size_t)(kt_) * 64 * 4096; \
        __builtin_amdgcn_global_load_lds((const unsigned*)(srcK + _ko), (__attribute__((address_space(3))) unsigned*)(lds + (bo_) + ldsw), 16, 0, 0); \
        __builtin_amdgcn_global_load_lds((const unsigned*)(srcK + _ko + 64), (__attribute__((address_space(3))) unsigned*)(lds + (bo_) + 8192 + ldsw), 16, 0, 0); \
        __builtin_amdgcn_global_load_lds((const unsigned*)(srcV0 + _ko), (__attribute__((address_space(3))) unsigned*)(lds + (bo_) + 16384 + ldsw), 16, 0, 0); \
        __builtin_amdgcn_global_load_lds((const unsigned*)(srcV1 + _ko), (__attribute__((address_space(3))) unsigned*)(lds + (bo_) + 24576 + ldsw), 16, 0, 0); } while (0)
    const int g_blk = (lane >> 4) & 1, g_q = (lane & 15) >> 2, g_p = lane & 3;
    bf16x8 pf[4];
    unsigned voff[8];
#pragma unroll
    for (int mo = 0; mo < 4; ++mo)
#pragma unroll
        for (int t = 0; t < 2; ++t) { const int row = 8 * t + 4 * hf + g_q, ch = 4 * mo + 2 * g_blk + (g_p >> 1); voff[2 * mo + t] = (unsigned)(row * 256 + ((ch ^ fxr(row)) << 4) + 8 * (g_p & 1)); }
    f32x16 st[2];
    float ps_acc = 0.f;
    auto exp_chunk = [&](int kk) {
        const int mt = kk >> 1, s8 = (kk & 1) * 8; float e[8];
#pragma unroll
        for (int i = 0; i < 8; ++i) e[i] = __builtin_amdgcn_exp2f(st[mt][s8 + i]);
        ps_acc += ((e[0] + e[1]) + (e[2] + e[3])) + ((e[4] + e[5]) + (e[6] + e[7]));
        u32x4 pw; pw.x = pk2(e[0], e[1]); pw.y = pk2(e[2], e[3]); pw.z = pk2(e[4], e[5]); pw.w = pk2(e[6], e[7]);
        pf[kk] = __builtin_bit_cast(bf16x8, pw);
    };
    auto do_pv = [&](int bo) {
        const unsigned vbase = (unsigned)(uintptr_t)(lds + bo + 16384);
        s16x4 la[4], ha[4]; unsigned ad[8];
#pragma unroll
        for (int i = 0; i < 8; ++i) ad[i] = vbase + voff[i];
        exp_chunk(0);
        tr8_issue_off<0>(la, ha, ad); exp_chunk(1); tr8_wait<0>(la, ha);
#pragma unroll
        for (int mo = 0; mo < 4; ++mo) o[mo] = __builtin_amdgcn_mfma_f32_32x32x16_bf16(cat8(la[mo], ha[mo]), pf[0], o[mo], 0, 0, 0);
        asm volatile("s_nop 7\n\ts_nop 7" ::: "memory");
        tr8_issue_off<4096>(la, ha, ad); exp_chunk(2); tr8_wait<0>(la, ha);
#pragma unroll
        for (int mo = 0; mo < 4; ++mo) o[mo] = __builtin_amdgcn_mfma_f32_32x32x16_bf16(cat8(la[mo], ha[mo]), pf[1], o[mo], 0, 0, 0);
        asm volatile("s_nop 7\n\ts_nop 7" ::: "memory");
        tr8_issue_off<8192>(la, ha, ad); exp_chunk(3); tr8_wait<0>(la, ha);
#pragma unroll
        for (int mo = 0; mo < 4; ++mo) o[mo] = __builtin_amdgcn_mfma_f32_32x32x16_bf16(cat8(la[mo], ha[mo]), pf[2], o[mo], 0, 0, 0);
        asm volatile("s_nop 7\n\ts_nop 7" ::: "memory");
        tr8_issue_off<12288>(la, ha, ad); tr8_wait<0>(la, ha);
#pragma unroll
        for (int mo = 0; mo < 4; ++mo) o[mo] = __builtin_amdgcn_mfma_f32_32x32x16_bf16(cat8(la[mo], ha[mo]), pf[3], o[mo], 0, 0, 0);
    };
    auto do_pv_plain = [&](int bo) {
        const unsigned vbase = (unsigned)(uintptr_t)(lds + bo + 16384);
        s16x4 la[4], ha[4]; unsigned ad[8];
#pragma unroll
        for (int i = 0; i < 8; ++i) ad[i] = vbase + voff[i];
        tr8_issue_off<0>(la, ha, ad); tr8_wait<0>(la, ha);
#pragma unroll
        for (int mo = 0; mo < 4; ++mo) o[mo] = __builtin_amdgcn_mfma_f32_32x32x16_bf16(cat8(la[mo], ha[mo]), pf[0], o[mo], 0, 0, 0);
        asm volatile("s_nop 7\n\ts_nop 7" ::: "memory");
        tr8_issue_off<4096>(la, ha, ad); tr8_wait<0>(la, ha);
#pragma unroll
        for (int mo = 0; mo < 4; ++mo) o[mo] = __builtin_amdgcn_mfma_f32_32x32x16_bf16(cat8(la[mo], ha[mo]), pf[1], o[mo], 0, 0, 0);
        asm volatile("s_nop 7\n\ts_nop 7" ::: "memory");
        tr8_issue_off<8192>(la, ha, ad); tr8_wait<0>(la, ha);
#pragma unroll
        for (int mo = 0; mo < 4; ++mo) o[mo] = __builtin_amdgcn_mfma_f32_32x32x16_bf16(cat8(la[mo], ha[mo]), pf[2], o[mo], 0, 0, 0);
        asm volatile("s_nop 7\n\ts_nop 7" ::: "memory");
        tr8_issue_off<12288>(la, ha, ad); tr8_wait<0>(la, ha);
#pragma unroll
        for (int mo = 0; mo < 4; ++mo) o[mo] = __builtin_amdgcn_mfma_f32_32x32x16_bf16(cat8(la[mo], ha[mo]), pf[3], o[mo], 0, 0, 0);
    };
    __syncthreads();
    AT_DMA(nkt - 1, 0);
    asm volatile("s_waitcnt vmcnt(0)" ::: "memory");
    __syncthreads();
    int bo_cur = 0, bo_nxt = 32768, bo_prv = 65536;
    bool first = true, pending = false;
    float m_base = 0.f;
#pragma unroll 1
    for (int kt = nkt - 1; kt >= 0; --kt) {
        if (kt > 0) AT_DMA(kt - 1, bo_nxt);
        const bool skip = (64 * kt > q0 + 32 * w + 31);
        if (j == 1 && pending) do_pv_plain(bo_prv);
        if (!skip) {
            bf16x8 kf[8];
            { const lds_uc* kb = lds + bo_cur + j * 8192;
#pragma unroll
              for (int i = 0; i < 8; ++i) { const int mt = i >> 2, ks = i & 3, row = 32 * mt + l32, ch = 2 * ks + hf;
                  kf[i] = *(const __attribute__((address_space(3))) bf16x8*)(kb + row * 128 + ((ch ^ ((row >> 1) & 7)) << 4)); } }
            const float kbias = slope2 * (float)(64 * kt - q0 + 4 * hf) - m_base;
#pragma unroll
            for (int mt = 0; mt < 2; ++mt)
#pragma unroll
                for (int r = 0; r < 16; ++r) st[mt][r] = kbias + slope2 * (float)(32 * mt + (r & 3) + 8 * (r >> 2));
            __builtin_amdgcn_s_setprio(1);
#pragma unroll
            for (int ks = 0; ks < 4; ++ks)
#pragma unroll
                for (int mt = 0; mt < 2; ++mt) st[mt] = __builtin_amdgcn_mfma_f32_32x32x16_bf16(kf[mt * 4 + ks], qf[ks], st[mt], 0, 0, 0);
            __builtin_amdgcn_s_setprio(0);
            const bool diag = (64 * kt + 63 > q0 + 32 * w);
            if (diag) {
                const int qrel = q0 + 32 * w + l32 - 64 * kt - 4 * hf;
#pragma unroll
                for (int mt = 0; mt < 2; ++mt)
#pragma unroll
                    for (int r = 0; r < 16; ++r) { const int ko = 32 * mt + (r & 3) + 8 * (r >> 2); if (ko > qrel) st[mt][r] = NEG_INF; }
            }
            float tm = NEG_INF;
#pragma unroll
            for (int mt = 0; mt < 2; ++mt)
#pragma unroll
                for (int r = 0; r < 16; r += 2) tm = fmaxf(fmaxf(st[mt][r], st[mt][r + 1]), tm);
            tm = max_xor32(tm);
            const bool need = first || (tm > 8.f);
            if (__any(need)) {
                const float dm = need ? tm : 0.f;
                const float alpha = __builtin_amdgcn_exp2f(-dm);
                m_base += dm; l_run *= alpha;
#pragma unroll
                for (int mt = 0; mt < 2; ++mt)
#pragma unroll
                    for (int r = 0; r < 16; ++r) st[mt][r] -= dm;
#pragma unroll
                for (int mo = 0; mo < 4; ++mo)
#pragma unroll
                    for (int r = 0; r < 16; ++r) o[mo][r] *= alpha;
            }
            first = false;
            ps_acc = 0.f;
            if (j == 0) do_pv(bo_cur);
            else { exp_chunk(0); exp_chunk(1); exp_chunk(2); exp_chunk(3); pending = true; }
            l_run += ps_acc;
        }
        asm volatile("s_waitcnt vmcnt(0)" ::: "memory");
        __syncthreads();
        { const int t_ = bo_prv; bo_prv = bo_cur; bo_cur = bo_nxt; bo_nxt = t_; }
    }
    if (j == 1 && pending) do_pv_plain(bo_prv);
#undef AT_DMA
    const float l_tot = sum_xor32(l_run);
    float inv = 1.f / l_tot; if (j == 1) inv *= lam;
    __attribute__((address_space(3))) float* ex = (__attribute__((address_space(3))) float*)lds;
    __syncthreads();
    if (j == 1) {
#pragma unroll
        for (int mo = 0; mo < 4; ++mo)
#pragma unroll
            for (int r = 0; r < 16; ++r) ex[(w * 64 + mo * 16 + r) * 64 + lane] = o[mo][r] * inv;
    }
    __syncthreads();
    if (j == 0) {
        float sq = 0.f;
#pragma unroll
        for (int mo = 0; mo < 4; ++mo)
#pragma unroll
            for (int r = 0; r < 16; ++r) { const float v = o[mo][r] * inv - ex[(w * 64 + mo * 16 + r) * 64 + lane]; o[mo][r] = v; sq += v * v; }
        sq = sum_xor32(sq);
        const float rn = rsqrtf(sq * (1.f / 128.f) + 1e-5f) * oscale;
        const bf16_t* rowp = big + (rowbase + q0 + 32 * w + l32) * 4096 + h * 128;
        bf16_t* orow = osp + (rowbase + q0 + 32 * w + l32) * 1024 + h * 128;
#pragma unroll
        for (int mo = 0; mo < 4; ++mo)
#pragma unroll
            for (int rq = 0; rq < 4; ++rq) { const int dv = 32 * mo + 8 * rq + 4 * hf;
                const u32x2 gw = *(const u32x2*)(rowp + 3072 + dv); const f32x4 sg = *(const f32x4*)(subln_g + dv);
                f32x4 v;
                v[0] = o[mo][4 * rq + 0] * rn * sg[0] * siluf_(bflo(gw.x)); v[1] = o[mo][4 * rq + 1] * rn * sg[1] * siluf_(bfhi(gw.x));
                v[2] = o[mo][4 * rq + 2] * rn * sg[2] * siluf_(bflo(gw.y)); v[3] = o[mo][4 * rq + 3] * rn * sg[3] * siluf_(bfhi(gw.y));
                st_bf4(orow + dv, v); }
    }
}

DI void sgu_unit(bf16_t* z, int chunk, int g, const bf16_t* wsb, const float* bs, const float* lng, const float* lnb, const float* vst, char* lds_generic) {
    lds_uc* lds = (lds_uc*)lds_generic;
    const int tid = otid(), wid = __builtin_amdgcn_readfirstlane(tid >> 6), lane = tid & 63, tt = wid & 3, dh = wid >> 2, hf = lane >> 5, l32 = lane & 31;
    const int t0 = chunk * 128;
    __attribute__((address_space(3))) float* stt = (__attribute__((address_space(3))) float*)(lds + 72 * 1024);
    const int ch = tid & 31, r0 = tid >> 5;
    bf16_t* tile = z + (size_t)(t0 + r0) * 6144 + g * 256 + ch * 8;
    u32x4 raw[8];
#pragma unroll
    for (int i = 0; i < 8; ++i) raw[i] = *(const u32x4*)(tile + (size_t)(16 * i) * 6144 + 2048);
    const int nks = 2 * (tt + 1);
    bf16x8 wf[8];
#pragma unroll
    for (int ks = 0; ks < 8; ++ks) { if (ks < nks) wf[ks] = *(const bf16x8*)(wsb + ((size_t)g * 128 + 32 * tt + l32) * 128 + 16 * ks + 8 * hf); else wf[ks] = (bf16x8){0, 0, 0, 0, 0, 0, 0, 0}; }
    float gq[8], bq[8];
    { const f32x4 a = *(const f32x4*)(lng + g * 256 + ch * 8), b = *(const f32x4*)(lng + g * 256 + ch * 8 + 4), c = *(const f32x4*)(lnb + g * 256 + ch * 8), d = *(const f32x4*)(lnb + g * 256 + ch * 8 + 4);
#pragma unroll
      for (int i = 0; i < 4; ++i) { gq[i] = a[i]; gq[4 + i] = b[i]; bq[i] = c[i]; bq[4 + i] = d[i]; } }
    const float bsv = bs[g * 128 + 32 * tt + l32];
    __syncthreads();
    if (tid < 128) { const f32x4* pv = (const f32x4*)(vst + (size_t)(t0 + tid) * 64); float s1 = 0.f, s2 = 0.f;
#pragma unroll
        for (int i = 0; i < 16; ++i) { const f32x4 q4 = pv[i]; s1 += q4[0] + q4[2]; s2 += q4[1] + q4[3]; }
        const float mu = s1 * (1.f / 2048.f), var = s2 * (1.f / 2048.f) - mu * mu;
        stt[2 * tid] = mu; stt[2 * tid + 1] = rsqrtf(fmaxf(var, 0.f) + 1e-5f); }
    __syncthreads();
#pragma unroll
    for (int i = 0; i < 8; ++i) { const int row = r0 + 16 * i;
        const float mu = stt[2 * row], rstd = stt[2 * row + 1];
        float f[8]; f[0] = bflo(raw[i].x); f[1] = bfhi(raw[i].x); f[2] = bflo(raw[i].y); f[3] = bfhi(raw[i].y); f[4] = bflo(raw[i].z); f[5] = bfhi(raw[i].z); f[6] = bflo(raw[i].w); f[7] = bfhi(raw[i].w);
#pragma unroll
        for (int e = 0; e < 8; ++e) f[e] = (f[e] - mu) * rstd * gq[e] + bq[e];
        u32x4 w4; w4.x = pk2(f[0], f[1]); w4.y = pk2(f[2], f[3]); w4.z = pk2(f[4], f[5]); w4.w = pk2(f[6], f[7]);
        *(__attribute__((address_space(3))) u32x4*)(lds + row * 512 + ((ch ^ fxr(row)) << 4)) = w4; }
    __syncthreads();
    u32x4 uq[8], gt[8];
#pragma unroll
    for (int i = 0; i < 8; ++i) { uq[i] = *(const u32x4*)(tile + (size_t)(16 * i) * 6144); gt[i] = *(const u32x4*)(tile + (size_t)(16 * i) * 6144 + 4096); }
    f32x16 acc[4];
#pragma unroll
    for (int mo = 0; mo < 4; ++mo)
#pragma unroll
        for (int r = 0; r < 16; ++r) acc[mo][r] = 0.f;
    const int g_blk = (lane >> 4) & 1, g_q = (lane & 15) >> 2, g_p = lane & 3;
    auto ld_frag = [&](int ks, bf16x8 (&vf)[4]) {
#pragma unroll
        for (int mo = 0; mo < 4; ++mo) {
            const int row0 = 16 * ks + 8 * hf + g_q, row1 = row0 + 4, chx = 4 * (dh * 4 + mo) + 2 * g_blk + (g_p >> 1);
            const s16x4 lo = __builtin_amdgcn_ds_read_tr16_b64_v4i16((__attribute__((address_space(3))) s16x4*)(lds + row0 * 512 + ((chx ^ fxr(row0)) << 4) + 8 * (g_p & 1)));
            const s16x4 hi = __builtin_amdgcn_ds_read_tr16_b64_v4i16((__attribute__((address_space(3))) s16x4*)(lds + row1 * 512 + ((chx ^ fxr(row1)) << 4) + 8 * (g_p & 1)));
            vf[mo] = (bf16x8){lo[0], lo[1], lo[2], lo[3], hi[0], hi[1], hi[2], hi[3]};
        }
    };
    bf16x8 va[4], vb[4];
    ld_frag(0, va);
#pragma unroll
    for (int ks = 0; ks < 8; ks += 2) {
        if (ks < nks) {
            ld_frag(ks + 1, vb);
#pragma unroll
            for (int mo = 0; mo < 4; ++mo) acc[mo] = __builtin_amdgcn_mfma_f32_32x32x16_bf16(va[mo], wf[ks], acc[mo], 0, 0, 0);
            if (ks + 2 < nks) ld_frag(ks + 2, va);
#pragma unroll
            for (int mo = 0; mo < 4; ++mo) acc[mo] = __builtin_amdgcn_mfma_f32_32x32x16_bf16(vb[mo], wf[ks + 1], acc[mo], 0, 0, 0);
        }
    }
    __syncthreads();
#pragma unroll
    for (int mo = 0; mo < 4; ++mo)
#pragma unroll
        for (int rq = 0; rq < 4; ++rq) { const int d = (dh * 4 + mo) * 32 + 8 * rq + 4 * hf; u32x2 w2;
            w2.x = pk2(acc[mo][4 * rq + 0] + bsv, acc[mo][4 * rq + 1] + bsv); w2.y = pk2(acc[mo][4 * rq + 2] + bsv, acc[mo][4 * rq + 3] + bsv);
            *(__attribute__((address_space(3))) u32x2*)(lds + (32 * tt + l32) * 520 + d * 2) = w2; }
    __syncthreads();
#pragma unroll
    for (int i = 0; i < 8; ++i) { const int row = r0 + 16 * i;
        const u32x2 m0 = *(const __attribute__((address_space(3))) u32x2*)(lds + row * 520 + ch * 16), m1 = *(const __attribute__((address_space(3))) u32x2*)(lds + row * 520 + ch * 16 + 8);
        const u32x4 u4 = uq[i], g4 = gt[i]; u32x4 y;
        y.x = pk2(bflo(u4.x) * bflo(m0.x) * siluf_(bflo(g4.x)), bfhi(u4.x) * bfhi(m0.x) * siluf_(bfhi(g4.x)));
        y.y = pk2(bflo(u4.y) * bflo(m0.y) * siluf_(bflo(g4.y)), bfhi(u4.y) * bfhi(m0.y) * siluf_(bfhi(g4.y)));
        y.z = pk2(bflo(u4.z) * bflo(m1.x) * siluf_(bflo(g4.z)), bfhi(u4.z) * bfhi(m1.x) * siluf_(bfhi(g4.z)));
        y.w = pk2(bflo(u4.w) * bflo(m1.y) * siluf_(bflo(g4.w)), bfhi(u4.w) * bfhi(m1.y) * siluf_(bfhi(g4.w)));
        *(u32x4*)(tile + (size_t)(16 * i) * 6144) = y; }
}

DI float wave_sum(float v) {
#pragma unroll
    for (int o = 32; o > 0; o >>= 1) v += __shfl_xor(v, o);
    return v;
}

#define XB_TMO      128
#define XB_XCNT(j)  (256  + 64 * (j))
#define XB_XSUB(j)  (1280 + 64 * (j))
#define XB_XGEN(j)  (2304 + 64 * (j))
#define XB_TOP      3328
#define XB_TOPGEN   3392
#define XCD_BAR_WORDS 3456
#define XB_SPIN_CAP (1u << 18)
#define LAS __attribute__((address_space(3)))
DI unsigned xb_ld(unsigned* p)              { return __hip_atomic_load(p, __ATOMIC_RELAXED, __HIP_MEMORY_SCOPE_AGENT); }
DI unsigned xb_add(unsigned* p, unsigned v) { return __hip_atomic_fetch_add(p, v, __ATOMIC_RELAXED, __HIP_MEMORY_SCOPE_AGENT); }
DI unsigned xb_xcc_id() { return (unsigned)__builtin_amdgcn_s_getreg((3 << 11) | 20) & 0xFu; }
#define XB_SPIN(cond, bar) do { unsigned _sp = 0; while (cond) { __builtin_amdgcn_s_sleep(1); \
    if ((++_sp & 255u) == 0u) { if (xb_ld(&(bar)[XB_TMO])) break; if (_sp > XB_SPIN_CAP) { atomicAdd(&(bar)[XB_TMO], 1u); break; } } } } while (0)
struct XcdBarrier { unsigned* bar; unsigned x; volatile LAS unsigned* st; };
DI XcdBarrier xcd_barrier_post(unsigned* bar, volatile LAS unsigned* st) {
    XcdBarrier b; b.bar = bar; b.x = xb_xcc_id(); b.st = st;
    if (threadIdx.x == 0) (void)xb_add(&bar[XB_XCNT(b.x)], 1u);
    return b;
}
DI void xcd_barrier_complete(unsigned* bar, unsigned x, unsigned& nloc, unsigned& nx) {
    const unsigned G = gridDim.x * gridDim.y * gridDim.z;
    unsigned sum, cnt, mine, sp = 0u;
    for (;;) {
        sum = 0u; cnt = 0u; mine = 0u;
#pragma unroll
        for (unsigned j = 0; j < 16; ++j) { const unsigned c = xb_ld(&bar[XB_XCNT(j)]); sum += c; cnt += (c > 0u) ? 1u : 0u; mine = (j == x) ? c : mine; }
        if (sum == G) break;
        __builtin_amdgcn_s_sleep(1);
        if ((++sp & 255u) == 0u) { if (xb_ld(&bar[XB_TMO])) break; if (sp > XB_SPIN_CAP) { atomicAdd(&bar[XB_TMO], 1u); break; } }
    }
    nloc = mine > 0u ? mine : 1u; nx = cnt > 0u ? cnt : 1u;
}
template <class Work>
DI void xcd_barrier(const XcdBarrier& b, const Work& side_work) {
    asm volatile("s_waitcnt vmcnt(0)" ::: "memory");
    __syncthreads();
    if (threadIdx.x >= 64) side_work((int)threadIdx.x - 64);
    if (threadIdx.x == 0) {
        unsigned* bar = b.bar;
        __builtin_amdgcn_s_waitcnt(0);
        unsigned nloc = b.st[0], nx = b.st[1];
        if (nloc == 0u) { xcd_barrier_complete(bar, b.x, nloc, nx); b.st[0] = nloc; b.st[1] = nx; }
        const unsigned old = xb_add(&bar[XB_XSUB(b.x)], 1u);
        const unsigned gen = old / nloc;
        if (old + 1u == (gen + 1u) * nloc) {
            __builtin_amdgcn_fence(__ATOMIC_RELEASE, "agent");
            asm volatile("s_waitcnt vmcnt(0)" ::: "memory");
            const unsigned og = xb_add(&bar[XB_TOP], 1u);
            const unsigned tg = og / nx;
            if (og + 1u == (tg + 1u) * nx) xb_add(&bar[XB_TOPGEN], 1u);
            else XB_SPIN(xb_ld(&bar[XB_TOPGEN]) == tg, bar);
            __builtin_amdgcn_fence(__ATOMIC_ACQUIRE, "agent");
            xb_add(&bar[XB_XGEN(b.x)], 1u);
            asm volatile("s_waitcnt vmcnt(0)" ::: "memory");
        } else {
            XB_SPIN(xb_ld(&bar[XB_XGEN(b.x)]) == gen, bar);
            __builtin_amdgcn_fence(__ATOMIC_ACQUIRE, "agent");
            asm volatile("s_waitcnt vmcnt(0)" ::: "memory");
        }
    }
    __syncthreads();
}

typedef const __attribute__((address_space(4))) Params* kparams_t;
#define KP kparams_t pp = (kparams_t)__builtin_amdgcn_kernarg_segment_ptr(); asm volatile("" : "+s"(pp)); char* ws = pp->ws; (void)ws;
#define W_XB ((bf16_t*)(ws + OFF_XB))
#define W_BIG ((bf16_t*)(ws + OFF_BIG))
#define W_OSP ((bf16_t*)(ws + OFF_BIG + 256 * MiB))
#define W_WIN ((bf16_t*)(ws + OFF_WIN))
#define W_WOA ((bf16_t*)(ws + OFF_WOA))
#define W_WOS ((bf16_t*)(ws + OFF_WOS))
#define W_WP ((bf16_t*)(ws + OFF_WP))
#define W_WG ((bf16_t*)(ws + OFF_WG))
#define W_PB ((bf16_t*)(ws + OFF_PB))
#define W_SS ((float*)(ws + OFF_SS))
#define W_VST ((float*)(ws + OFF_VST))
#define W_WSB ((bf16_t*)(ws + OFF_WSB))

__global__ __launch_bounds__(512) void mega_fwd(Params P_unused) {
    extern __shared__ __attribute__((aligned(16))) char lds[];
    cg::grid_group grid = cg::this_grid();
    const int G = gridDim.x;
    __shared__ uint4 xb_words;
    if (threadIdx.x == 0) xb_words = make_uint4(0u, 0u, 0u, 0u);
    {
        PH_BEGIN(0)
        KP
        if (blockIdx.x == 0) { unsigned* bar = (unsigned*)(ws + OFF_BAR); for (int i = threadIdx.x; i < XCD_BAR_WORDS; i += 512) bar[i] = 0u; }
        {
            const int tx = otid();
            constexpr int I_WO = 1024 * 32, I_SO = 1024 * 64, I_PP = 1024 * 8, I_PG = 1024 * 32, I_WI = 4096 * 32;
            constexpr int total = 2 * I_WO + 2 * I_SO + 4 * I_PP + 4 * I_PG + I_WI;
            for (int it = blockIdx.x * 512 + tx; it < total; it += G * 512) {
                int r = it;
                if (r < 2 * I_WO) { const int j = r / I_WO; conv_item(pp->attn_w_out + (size_t)j * 1024 * 1024, 1024, 1024, W_WOA + (size_t)j * 1024 * 1024, nullptr, 0, 1.f, r % I_WO); continue; }
                r -= 2 * I_WO;
                if (r < 2 * I_SO) { const int j = r / I_SO; conv_item(pp->sgu_w_out + (size_t)j * 2048 * 1024, 2048, 1024, W_WOS + (size_t)j * 1024 * 2048, nullptr, 0, 1.f, r % I_SO); continue; }
                r -= 2 * I_SO;
                if (r < 4 * I_PP) { const int j = r / I_PP; conv_item(pp->ple_proj + (size_t)j * 256 * 1024, 256, 1024, W_WP + (size_t)j * 1024 * 256, nullptr, 0, 1.f, r % I_PP); continue; }
                r -= 4 * I_PP;
                if (r < 4 * I_PG) { const int j = r / I_PG; conv_item(pp->ple_gate + (size_t)j * 1024 * 1024, 1024, 1024, W_WG + (size_t)j * 1024 * 1024, nullptr, 0, 1.f, r % I_PG); continue; }
                r -= 4 * I_PG;
                conv_item(pp->attn_w_in, 1024, 4096, W_WIN, pp->attn_norm, 1024, 0.125f * LOG2E, r);
            }
        }
        { const int tid = otid(); const float* wsrc = pp->w_s; bf16_t* wdst = W_WSB;
          for (size_t e = (size_t)blockIdx.x * 512 + tid; e < (size_t)2 * 8 * 128 * 128; e += (size_t)G * 512) {
              const int s = (int)(e & 127), t = (int)((e >> 7) & 127);
              wdst[e] = (s <= t) ? f2bf(wsrc[e]) : (bf16_t)0; } }
        { const int tid = otid(), wid = tid >> 6, lane = tid & 63; const float* x = pp->x; bf16_t* XB = W_XB; float* SS = W_SS;
          for (int row = blockIdx.x * 8 + wid; row < T_; row += G * 8) {
              const float* xr = x + (size_t)row * 1024; float sq = 0.f;
#pragma unroll
              for (int i = 0; i < 4; ++i) { const f32x4 v = *(const f32x4*)(xr + i * 256 + lane * 4); sq += (v[0] * v[0] + v[1] * v[1]) + (v[2] * v[2] + v[3] * v[3]);
                  st_bf4(XB + (size_t)row * 1024 + i * 256 + lane * 4, v); }
              sq = wave_sum(sq);
              if (lane < 16) SS[(size_t)row * 16 + lane] = (lane == 0) ? sq : 0.f; } }
        conv_flat(pp->p, W_PB, (size_t)T_ * 256);
        PH_END(0)
    }
    grid.sync();
    { KP (void)xcd_barrier_post((unsigned*)(ws + OFF_BAR), (volatile LAS unsigned*)&xb_words); }
#define XBAR_W(WORK) do { KP XcdBarrier xb_; xb_.bar = (unsigned*)(ws + OFF_BAR); xb_.x = xb_xcc_id(); xb_.st = (volatile LAS unsigned*)&xb_words; xcd_barrier(xb_, WORK); } while (0)
#define XBAR XBAR_W([](int) {})

#pragma unroll 1
    for (int layer = 0; layer < 4; ++layer) {
        const int jl = layer >> 1;
        if ((layer & 1) == 0) {
            { PH_BEGIN(1)
            { KP EpiQKVG epi{W_BIG, W_SS}; gemm_phase(lds, W_XB, 1024, W_WIN, 1024, 1024, T_, 4096, epi, STAGGER_TICKS); }
            PH_END(1) }
            XBAR_W([&](int lt) { if (layer > 0) conv_flat_part(pp->p + (size_t)layer * T_ * 256, W_PB, (size_t)T_ * 256, lt, 448, 1, 2); });
            for (int rep = 0; rep < PROBE_ATTN_REPS; ++rep) {
                PH_BEGIN(2)
                KP
                float lam; const int lane = otid() & 63;
                const float li = (layer == 0 ? pp->lam_init0 : pp->lam_init2);
                { const float a = pp->lq1[jl * 64 + lane] * pp->lk1[jl * 64 + lane], b2 = pp->lq2[jl * 64 + lane] * pp->lk2[jl * 64 + lane];
                  lam = __expf(wave_sum(a)) - __expf(wave_sum(b2)) + li; }
                const float oscale = 1.f - li;
                const float* sg = pp->subln + jl * 128;
                bf16_t* BIG = W_BIG; bf16_t* OSP = W_OSP;
#pragma unroll 1
                for (int pr = blockIdx.x; pr < 1024; pr += G) {
                    const int c = pr & 255, i = pr >> 8, xcd = c & 7, slot = c >> 3;
                    const int bh = i * 16 + xcd * 2 + (slot >> 4), pq = slot & 15, b = bh >> 3, h = bh & 7;
                    const float slope2 = exp2f(-(float)(h + 1)) * LOG2E;
                    attn_unit(BIG, OSP, b, h, 31 - pq, lam, slope2, sg, oscale, lds);
                    attn_unit(BIG, OSP, b, h, pq, lam, slope2, sg, oscale, lds);
                }
                PH_END(2)
            }
            XBAR_W([&](int lt) { conv_T_part(pp->sgu_w_in + (size_t)jl * 1024 * 6144, 1024, 6144, W_WIN, pp->sgu_norm + jl * 1024, 0, 1.f, lt, 448, 0, 2); });
            { PH_BEGIN(3)
            { KP EpiRes epi{W_XB, W_BIG + 2048, 4096}; gemm_phase(lds, W_OSP, 1024, W_WOA + (size_t)jl * 1024 * 1024, 1024, 1024, T_, 1024, epi); }
            { KP EpiE epi{W_BIG + 1024, 4096}; gemm_phase(lds, W_PB, 256, W_WP + (size_t)layer * 1024 * 256, 256, 256, T_, 1024, epi); }
            PH_END(3) }
            XBAR_W([&](int lt) { conv_T_part(pp->sgu_w_in + (size_t)jl * 1024 * 6144, 1024, 6144, W_WIN, pp->sgu_norm + jl * 1024, 0, 1.f, lt, 448, 1, 2); });
            { PH_BEGIN(4)
            { KP EpiGate epi{W_BIG + 2048, 4096, W_BIG + 1024, 4096, W_XB, W_SS}; gemm_phase(lds, W_BIG + 2048, 4096, W_WG + (size_t)layer * 1024 * 1024, 1024, 1024, T_, 1024, epi); }
            PH_END(4) }
            XBAR_W([&](int lt) { conv_flat_part(pp->p + (size_t)(layer + 1) * T_ * 256, W_PB, (size_t)T_ * 256, lt, 448, 0, 2); });
        } else {
            { PH_BEGIN(5)
            { KP EpiSguIn epi{W_BIG, W_SS, W_VST}; gemm_phase(lds, W_XB, 1024, W_WIN, 1024, 1024, T_, 6144, epi, STAGGER_TICKS); }
            PH_END(5) }
            XBAR_W([&](int lt) { if (layer > 0) conv_flat_part(pp->p + (size_t)layer * T_ * 256, W_PB, (size_t)T_ * 256, lt, 448, 1, 2); });
            { PH_BEGIN(6) KP
              const bf16_t* wsb = W_WSB + (size_t)jl * 8 * 128 * 128; const float* bs = pp->b_s + jl * 8 * 128; const float* lg = pp->ln_g + jl * 2048; const float* lb = pp->ln_b + jl * 2048;
              bf16_t* BIG = W_BIG; const float* VST = W_VST;
#pragma unroll 1
              for (int u = blockIdx.x; u < 2048; u += G) sgu_unit(BIG, u >> 3, u & 7, wsb, bs, lg, lb, VST, lds);
              PH_END(6) }
            XBAR_W([&](int lt) { if (layer + 1 < 4) conv_T_part(pp->attn_w_in + (size_t)(jl + 1) * 1024 * 4096, 1024, 4096, W_WIN, pp->attn_norm + (jl + 1) * 1024, 1024, 0.125f * LOG2E, lt, 448, 0, 2); });
            { PH_BEGIN(7)
            { KP EpiRes epi{W_XB, W_BIG + 4096, 6144}; gemm_phase(lds, W_BIG, 6144, W_WOS + (size_t)jl * 1024 * 2048, 2048, 2048, T_, 1024, epi); }
            { KP EpiE epi{W_BIG + 2048, 6144}; gemm_phase(lds, W_PB, 256, W_WP + (size_t)layer * 1024 * 256, 256, 256, T_, 1024, epi); }
            PH_END(7) }
            XBAR_W([&](int lt) { if (layer + 1 < 4) conv_T_part(pp->attn_w_in + (size_t)(jl + 1) * 1024 * 4096, 1024, 4096, W_WIN, pp->attn_norm + (jl + 1) * 1024, 1024, 0.125f * LOG2E, lt, 448, 1, 2); });
            { PH_BEGIN(8)
            { KP EpiGate epi{W_BIG + 4096, 6144, W_BIG + 2048, 6144, W_XB, W_SS}; gemm_phase(lds, W_BIG + 4096, 6144, W_WG + (size_t)layer * 1024 * 1024, 1024, 1024, T_, 1024, epi); }
            PH_END(8) }
            XBAR_W([&](int lt) { if (layer + 1 < 4) conv_flat_part(pp->p + (size_t)(layer + 1) * T_ * 256, W_PB, (size_t)T_ * 256, lt, 448, 0, 2); });
        }
    }
    {
        PH_BEGIN(9)
        KP
        const int tid = otid(), wid = tid >> 6, lane = tid & 63; float* OUT = pp->out; const bf16_t* XB = W_XB; const float* SS = W_SS; const float* fg = pp->final_norm;
        for (int row = blockIdx.x * 8 + wid; row < T_; row += G * 8) {
            const float rs = rs_from_ss(SS, row);
#pragma unroll
            for (int i = 0; i < 2; ++i) { const int c = i * 512 + lane * 8; const u32x4 xw = *(const u32x4*)(XB + (size_t)row * 1024 + c);
                const f32x4 g0 = *(const f32x4*)(fg + c), g1 = *(const f32x4*)(fg + c + 4);
                f32x4 o0, o1; o0[0] = bflo(xw.x) * rs * g0[0]; o0[1] = bfhi(xw.x) * rs * g0[1]; o0[2] = bflo(xw.y) * rs * g0[2]; o0[3] = bfhi(xw.y) * rs * g0[3];
                o1[0] = bflo(xw.z) * rs * g1[0]; o1[1] = bfhi(xw.z) * rs * g1[1]; o1[2] = bflo(xw.w) * rs * g1[2]; o1[3] = bfhi(xw.w) * rs * g1[3];
                *(f32x4*)(OUT + (size_t)row * 1024 + c) = o0; *(f32x4*)(OUT + (size_t)row * 1024 + c + 4) = o1; }
        }
        PH_END(9)
    }
}

extern "C" void kernel_launch(void* const* d_in, const int* in_sizes, int n_in, void* d_out, int out_size, void* d_ws, size_t ws_size, hipStream_t stream) {
    static int grid_blocks = 0;
    if (!grid_blocks) {
        int dev = 0, cus = 0, per_cu = 0;
        hipGetDevice(&dev);
        hipDeviceGetAttribute(&cus, hipDeviceAttributeMultiprocessorCount, dev);
        hipFuncSetAttribute((const void*)mega_fwd, hipFuncAttributeMaxDynamicSharedMemorySize, LDS_BYTES);
        hipOccupancyMaxActiveBlocksPerMultiprocessor(&per_cu, mega_fwd, 512, LDS_BYTES);
        if (per_cu < 1) per_cu = 1;
        grid_blocks = cus * 1;
    }
    Params P{};
    const float** pp = (const float**)&P;
    for (int i = 0; i < 20; ++i) pp[i] = (const float*)d_in[i];
    P.out = (float*)d_out; P.ws = (char*)d_ws;
    P.lam_init0 = 0.2f; P.lam_init2 = (float)(0.8 - 0.6 * 0.54881163609402643);
    void* args[] = {&P};
    hipError_t e = hipLaunchCooperativeKernel((void*)mega_fwd, dim3(grid_blocks), dim3(512), args, LDS_BYTES, stream);
    if (e != hipSuccess) fprintf(stderr, "cooperative launch failed: %s (grid %d)\n", hipGetErrorString(e), grid_blocks);
}
```

```cpp
#include <hip/hip_runtime.h>
#include <hip/hip_cooperative_groups.h>
#include <cstdio>
#include <cstdint>
namespace cg = cooperative_groups;

#define DI __device__ __forceinline__
typedef unsigned short bf16_t;
typedef short bf16x8 __attribute__((ext_vector_type(8)));
typedef short s16x4 __attribute__((ext_vector_type(4)));
typedef float f32x2 __attribute__((ext_vector_type(2)));
typedef float f32x4 __attribute__((ext_vector_type(4)));
typedef float f32x16 __attribute__((ext_vector_type(16)));
typedef __bf16 bf16x2v __attribute__((ext_vector_type(2)));
typedef unsigned u32x2 __attribute__((ext_vector_type(2)));
typedef unsigned u32x4 __attribute__((ext_vector_type(4)));

constexpr int T_ = 32768, S_ = 4096;
constexpr size_t MiB = 1024 * 1024;
constexpr size_t OFF_XB = 0, OFF_BIG = 64 * MiB, OFF_WIN = 448 * MiB, OFF_WOA = 460 * MiB, OFF_WOS = 464 * MiB, OFF_WP = 472 * MiB,
                 OFF_WG = 474 * MiB, OFF_PB = 482 * MiB, OFF_SS = 498 * MiB, OFF_VST = 500 * MiB, OFF_WSB = 508 * MiB, OFF_BAR = 509 * MiB;
constexpr int LDS_BYTES = 128 * 1024;
#define STAGGER_TICKS 0
#ifndef PROBE_MASK
#define PROBE_MASK 0
#endif
#define PH_BEGIN(id) unsigned long long _pt0 = 0; if (PROBE_MASK & (1 << (id))) _pt0 = __builtin_amdgcn_s_memrealtime();
#define PH_END(id) if (PROBE_MASK & (1 << (id))) { const unsigned long long _pt1 = __builtin_amdgcn_s_memrealtime(); while (__builtin_amdgcn_s_memrealtime() - _pt1 < _pt1 - _pt0) __builtin_amdgcn_s_sleep(8); }
#ifndef PROBE_ATTN_REPS
#define PROBE_ATTN_REPS 1
#endif
#define LOG2E 1.4426950408889634f

struct Params {
    const float *x, *p, *attn_norm, *attn_w_in, *lq1, *lk1, *lq2, *lk2, *subln, *attn_w_out, *sgu_norm, *sgu_w_in, *ln_g, *ln_b, *w_s, *b_s,
        *sgu_w_out, *ple_proj, *ple_gate, *final_norm;
    float* out;
    char* ws;
    float lam_init0, lam_init2;
};

DI int otid() { int t = threadIdx.x; asm volatile("" : "+v"(t)); return t; }
DI float sum_xor32(float v) { const u32x2 r = __builtin_amdgcn_permlane32_swap(__float_as_uint(v), __float_as_uint(v), false, false); return __uint_as_float(r[0]) + __uint_as_float(r[1]); }
DI float max_xor32(float v) { const u32x2 r = __builtin_amdgcn_permlane32_swap(__float_as_uint(v), __float_as_uint(v), false, false); return fmaxf(__uint_as_float(r[0]), __uint_as_float(r[1])); }
DI float sum_xor16(float v) { const u32x2 r = __builtin_amdgcn_permlane16_swap(__float_as_uint(v), __float_as_uint(v), false, false); return __uint_as_float(r[0]) + __uint_as_float(r[1]); }
DI unsigned pk2(float a, float b) { f32x2 v = {a, b}; return __builtin_bit_cast(unsigned, __builtin_convertvector(v, bf16x2v)); }
DI bf16_t f2bf(float a) { return (bf16_t)(pk2(a, 0.f) & 0xffffu); }
DI float bflo(unsigned u) { return __uint_as_float(u << 16); }
DI float bfhi(unsigned u) { return __uint_as_float(u & 0xffff0000u); }
DI float sigmoidf_(float x) { return __builtin_amdgcn_rcpf(1.f + __builtin_amdgcn_exp2f(-x * LOG2E)); }
DI float siluf_(float x) { return x * sigmoidf_(x); }
DI f32x2 gelu_pk(f32x2 v) {
    const f32x2 av = __builtin_elementwise_abs(v), d = av * 0.2316418882f + 1.0f;
    f32x2 t; t.x = __builtin_amdgcn_rcpf(d.x); t.y = __builtin_amdgcn_rcpf(d.y);
    f32x2 q = t * 0.5307027145f + (-0.7265760135f); q = q * t + 0.7107068705f; q = q * t + (-0.142248368f); q = q * t + 0.127414796f; q = q * t;
    const f32x2 s = (v * v) * (-0.72134752044f);
    f32x2 e; e.x = __builtin_amdgcn_exp2f(s.x); e.y = __builtin_amdgcn_exp2f(s.y);
    const f32x2 m = v * (q * e), r = v - m;
    f32x2 o; o.x = v.x < 0.f ? m.x : r.x; o.y = v.y < 0.f ? m.y : r.y; return o;
}
DI int fxr(int row) { return ((row & 3) << 2) | ((row >> 2) & 3); }

DI void conv_item(const float* src, int K, int N, bf16_t* dst, const float* gain, int nscale, float cs, int item) {
    const int n = item % N, kb = item / N;
    const float* sp = src + (size_t)(kb * 32) * N + n;
    float v[32];
#pragma unroll
    for (int i = 0; i < 32; ++i) v[i] = sp[(size_t)i * N];
    const float sc = (n < nscale) ? cs : 1.f;
    if (gain) {
#pragma unroll
        for (int i = 0; i < 32; ++i) v[i] *= gain[kb * 32 + i];
    }
    bf16_t* dp = dst + (size_t)n * K + kb * 32;
#pragma unroll
    for (int q = 0; q < 4; ++q) { u32x4 w; w.x = pk2(v[8 * q] * sc, v[8 * q + 1] * sc); w.y = pk2(v[8 * q + 2] * sc, v[8 * q + 3] * sc);
        w.z = pk2(v[8 * q + 4] * sc, v[8 * q + 5] * sc); w.w = pk2(v[8 * q + 6] * sc, v[8 * q + 7] * sc); *(u32x4*)(dp + 8 * q) = w; }
}
DI void conv_T_part(const float* src, int K, int N, bf16_t* dst, const float* gain, int nscale, float cs, int lt, int nt, int part, int nparts) {
    const int total = N * (K >> 5), lo = (int)((long)total * part / nparts), hi = (int)((long)total * (part + 1) / nparts);
    for (int item = lo + blockIdx.x * nt + lt; item < hi; item += gridDim.x * nt) conv_item(src, K, N, dst, gain, nscale, cs, item);
}
DI void conv_flat_part(const float* src, bf16_t* dst, size_t n, int lt, int nt, int part, int nparts) {
    const size_t nch = n / 8, lo = nch * part / nparts, hi = nch * (part + 1) / nparts;
    for (size_t c = lo + (size_t)blockIdx.x * nt + lt; c < hi; c += (size_t)gridDim.x * nt) {
        const f32x4 a = *(const f32x4*)(src + c * 8), b = *(const f32x4*)(src + c * 8 + 4);
        u32x4 w; w.x = pk2(a[0], a[1]); w.y = pk2(a[2], a[3]); w.z = pk2(b[0], b[1]); w.w = pk2(b[2], b[3]);
        *(u32x4*)(dst + c * 8) = w;
    }
}
DI void conv_T(const float* src, int K, int N, bf16_t* dst, const float* gain, int nscale, float cs, char*) {
    const int tx = otid();
    const int total = N * (K >> 5);
    for (int item = blockIdx.x * 512 + tx; item < total; item += gridDim.x * 512) conv_item(src, K, N, dst, gain, nscale, cs, item);
}
DI void conv_flat(const float* src, bf16_t* dst, size_t n) {
    const size_t nch = n / 8;
    const int tx = otid();
    for (size_t c = (size_t)blockIdx.x * 512 + tx; c < nch; c += (size_t)gridDim.x * 512) {
        const f32x4 a = *(const f32x4*)(src + c * 8), b = *(const f32x4*)(src + c * 8 + 4);
        u32x4 w; w.x = pk2(a[0], a[1]); w.y = pk2(a[2], a[3]); w.z = pk2(b[0], b[1]); w.w = pk2(b[2], b[3]);
        *(u32x4*)(dst + c * 8) = w;
    }
}

typedef __attribute__((address_space(3))) unsigned char lds_uc;
constexpr int HTB = 128 * 64 * 2;
DI int lds_byte(int r, int c) { const int st = (r >> 4) * 2 + (c >> 5), rr = r & 15, cc = c & 31, ob = rr * 64 + cc * 2; return st * 1024 + (ob ^ (((ob >> 9) & 1) << 5)); }
DI void stage_rc(int b, int& R, int& C) { const int st = b / 1024, sb = b % 1024, swz = sb ^ (((sb >> 9) & 1) << 5); R = (st >> 1) * 16 + swz / 64; C = (st & 1) * 32 + (swz % 64) / 2; }
#ifndef WGM_
#define WGM_ 4
#endif
struct Unit { int pm, pn; };
struct StaticOrder {
    int nM, nN, nwg, G, c;
    DI void init(int M, int N, int G_, int c_) { nM = M / 256; nN = N / 256; nwg = nM * nN; G = G_; c = c_; }
    DI bool next(int i, Unit& u) const {
        const long L = (long)i * G + c; if (L >= nwg) return false;
        int wgid = (int)L; { const int q = nwg / 8, r = nwg % 8, xcd = wgid % 8, off = wgid / 8; wgid = (xcd < r ? xcd * (q + 1) : r * (q + 1) + (xcd - r) * q) + off; }
        const int nig = WGM_ * nN, gid = wgid / nig, fm = gid * WGM_, gsz = (nM - fm) < WGM_ ? (nM - fm) : WGM_;
        u.pm = fm + ((wgid % nig) % gsz); u.pn = (wgid % nig) / gsz; return true;
    }
};

template <class Epi>
DI void gemm_phase(char* lds_generic, const bf16_t* A, int lda, const bf16_t* Bt, int ldb, int K, int M, int N, const Epi& E, int stagger_ticks = 0) {
    lds_uc* lds = (lds_uc*)lds_generic;
    const int tid = otid(), wid = __builtin_amdgcn_readfirstlane(tid >> 6), lane = tid & 63, wr = wid >> 2, wc = wid & 3, fr = lane & 15, fq = lane >> 4;
    StaticOrder S; S.init(M, N, gridDim.x, blockIdx.x);
    const int nt = K / 64;
    unsigned voffA[2], voffB[2];
#pragma unroll
    for (int i = 0; i < 2; ++i) { int R, C; stage_rc(tid * 16 + i * 8192, R, C); const int rho = R & 31, Rb = (R & ~31) + 8 * ((rho & 15) >> 2) + 4 * (rho >> 4) + (rho & 3);
        voffA[i] = (unsigned)(R * lda + C) * 2u; voffB[i] = (unsigned)(Rb * ldb + C) * 2u; }
    const size_t kstep = 128;
    const size_t hstepA = (size_t)128 * lda * 2, hstepB = (size_t)128 * ldb * 2, tstepA = 2 * hstepA, tstepB = 2 * hstepB;
    const unsigned ldsw = (unsigned)wid * 1024u;
    const int aoff = lds_byte(wr * 64 + fr, fq * 8), boff = lds_byte(wc * 32 + fr, fq * 8);
#define PG8_SA(b, h) (((b) * 2 + (h)) * HTB)
#define PG8_SB(b, h) ((4 + (b) * 2 + (h)) * HTB)
#define PG8_STAGE(bufoff, gbase, voff) do { _Pragma("unroll") for (int _i = 0; _i < 2; ++_i) \
        __builtin_amdgcn_global_load_lds((const unsigned*)((const char*)(gbase) + (voff)[_i]), (__attribute__((address_space(3))) unsigned*)(lds + (bufoff) + ldsw + _i * 8192), 16, 0, 0); } while (0)
#define PG8_LDA(dst, b, h) do { _Pragma("unroll") for (int m = 0; m < 4; ++m) _Pragma("unroll") for (int k = 0; k < 2; ++k) dst[m][k] = *(const __attribute__((address_space(3))) bf16x8*)(lds + PG8_SA(b, h) + aoff + m * 2048 + k * 1024); } while (0)
#define PG8_LDB(dst, b, h) do { _Pragma("unroll") for (int n = 0; n < 2; ++n) _Pragma("unroll") for (int k = 0; k < 2; ++k) dst[n][k] = *(const __attribute__((address_space(3))) bf16x8*)(lds + PG8_SB(b, h) + boff + n * 2048 + k * 1024); } while (0)
#define PG8_MMA(ai, bj, At, Bt_) do { __builtin_amdgcn_s_setprio(1); _Pragma("unroll") for (int m = 0; m < 4; ++m) _Pragma("unroll") for (int n = 0; n < 2; ++n) _Pragma("unroll") for (int k = 0; k < 2; ++k) \
        acc[ai][bj][m][n] = __builtin_amdgcn_mfma_f32_16x16x32_bf16(Bt_[n][k], At[m][k], acc[ai][bj][m][n], 0, 0, 0); __builtin_amdgcn_s_setprio(0); } while (0)
#define PG8_WAIT_V(n) asm volatile("s_waitcnt vmcnt(" #n ")" ::: "memory")
#define PG8_WAIT_L(n) asm volatile("s_waitcnt lgkmcnt(" #n ")" ::: "memory")
#define PG8_BAR __builtin_amdgcn_s_barrier()
#define PG8_SCHED __builtin_amdgcn_sched_barrier(0)
    Unit cur, nxt; int ui = 0;
    __syncthreads();
    if (!S.next(0, cur)) return;
    PG8_WAIT_V(0);
    if (stagger_ticks) {
        const unsigned long long t0 = __builtin_amdgcn_s_memrealtime(), dl = (unsigned long long)(((blockIdx.x >> 3) & 3) * stagger_ticks);
        while (__builtin_amdgcn_s_memrealtime() - t0 < dl) __builtin_amdgcn_s_sleep(8);
    }
    f32x4 acc[2][2][4][2];
#pragma unroll
    for (int a = 0; a < 2; ++a)
#pragma unroll
        for (int b = 0; b < 2; ++b)
#pragma unroll
            for (int m = 0; m < 4; ++m)
#pragma unroll
                for (int n = 0; n < 2; ++n) acc[a][b][m][n] = (f32x4){0.f, 0.f, 0.f, 0.f};
    bf16x8 At[4][2], B0[2][2], B1[2][2];
    const char* cA = (const char*)A + (size_t)cur.pm * tstepA; const char* cB = (const char*)Bt + (size_t)cur.pn * tstepB;
    PG8_STAGE(PG8_SB(0, 0), cB, voffB); PG8_STAGE(PG8_SB(0, 1), cB + hstepB, voffB); PG8_STAGE(PG8_SA(0, 0), cA, voffA); PG8_STAGE(PG8_SA(0, 1), cA + hstepA, voffA);
    if (wr == 1) PG8_BAR;
    PG8_WAIT_V(2); PG8_BAR;
    PG8_STAGE(PG8_SB(1, 0), cB + kstep, voffB); PG8_STAGE(PG8_SA(1, 0), cA + kstep, voffA); PG8_STAGE(PG8_SB(1, 1), cB + hstepB + kstep, voffB);
    PG8_WAIT_V(6); PG8_BAR;
    for (;;) {
        const bool has_next = S.next(ui + 1, nxt);
        const char* nA = has_next ? (const char*)A + (size_t)nxt.pm * tstepA : cA; const char* nB = has_next ? (const char*)Bt + (size_t)nxt.pn * tstepB : cB;
#pragma unroll 1
        for (int t = 0; t < nt; t += 2) {
            const bool last = (t == nt - 2);
            const char* a1 = cA + (size_t)(t + 1) * kstep;
            const char* a2 = last ? nA : cA + (size_t)(t + 2) * kstep; const char* b2 = last ? nB : cB + (size_t)(t + 2) * kstep;
            const char* a3 = a2 + kstep; const char* b3 = b2 + kstep;
            PG8_LDB(B0, 0, 0); PG8_LDB(B1, 0, 1); PG8_SCHED; PG8_LDA(At, 0, 0); PG8_STAGE(PG8_SA(1, 1), a1 + hstepA, voffA);
            PG8_WAIT_V(8); PG8_WAIT_L(0); PG8_BAR; PG8_MMA(0, 0, At, B0); PG8_MMA(0, 1, At, B1); PG8_BAR; PG8_SCHED;
            PG8_LDA(At, 0, 1); PG8_STAGE(PG8_SB(0, 0), b2, voffB); PG8_STAGE(PG8_SB(0, 1), b2 + hstepB, voffB); PG8_STAGE(PG8_SA(0, 0), a2, voffA);
            PG8_WAIT_V(8); PG8_WAIT_L(0); PG8_BAR; PG8_MMA(1, 0, At, B0); PG8_MMA(1, 1, At, B1); PG8_BAR; PG8_SCHED;
            PG8_LDB(B0, 1, 0); PG8_LDB(B1, 1, 1); PG8_SCHED; PG8_LDA(At, 1, 0); PG8_STAGE(PG8_SA(0, 1), a2 + hstepA, voffA);
            PG8_WAIT_V(8); PG8_WAIT_L(0); PG8_BAR; PG8_MMA(0, 0, At, B0); PG8_MMA(0, 1, At, B1); PG8_BAR; PG8_SCHED;
            PG8_LDA(At, 1, 1); PG8_STAGE(PG8_SB(1, 0), b3, voffB); PG8_STAGE(PG8_SB(1, 1), b3 + hstepB, voffB); PG8_STAGE(PG8_SA(1, 0), a3, voffA);
            PG8_WAIT_V(8); PG8_WAIT_L(0); PG8_BAR; PG8_MMA(1, 0, At, B0); PG8_MMA(1, 1, At, B1); PG8_BAR; PG8_SCHED;
        }
        if (wr == 0) PG8_BAR;
        E(acc, cur.pm, cur.pn, wr, wc, fr, fq);
        if (!has_next) break;
#pragma unroll
        for (int a = 0; a < 2; ++a)
#pragma unroll
            for (int b = 0; b < 2; ++b)
#pragma unroll
                for (int m = 0; m < 4; ++m)
#pragma unroll
                    for (int n = 0; n < 2; ++n) acc[a][b][m][n] = (f32x4){0.f, 0.f, 0.f, 0.f};
        cur = nxt; cA = nA; cB = nB; ++ui;
        if (wr == 1) PG8_BAR;
    }
    PG8_WAIT_V(0);
    PG8_BAR;
}

#define EPI_ARGS const f32x4 (&acc)[2][2][4][2], int pm, int pn, int wr, int wc, int fr, int fq
#define ROW_OF(ai, m) (pm * 256 + (ai) * 128 + wr * 64 + (m) * 16 + fr)
#define COL_OF(bj) (pn * 256 + (bj) * 128 + wc * 32 + fq * 8)
DI float quad_sum(float v) { return sum_xor32(sum_xor16(v)); }
DI float rs_from_ss(const float* ss, int row) {
    const f32x4* p = (const f32x4*)(ss + (size_t)row * 16); const f32x4 s = (p[0] + p[1]) + (p[2] + p[3]);
    return rsqrtf(((s[0] + s[1]) + (s[2] + s[3])) * (1.f / 1024.f) + 1e-6f); }
DI float rs_from_ss_q(const float* ss, int row, int fq) {
    const f32x4 s = *(const f32x4*)(ss + (size_t)row * 16 + fq * 4);
    return rsqrtf(quad_sum((s[0] + s[1]) + (s[2] + s[3])) * (1.f / 1024.f) + 1e-6f); }
DI void st_bf4(bf16_t* p, f32x4 v) { u32x2 w; w.x = pk2(v[0], v[1]); w.y = pk2(v[2], v[3]); *(u32x2*)p = w; }
DI void st_bf8(bf16_t* p, f32x4 a, f32x4 b) { u32x4 w; w.x = pk2(a[0], a[1]); w.y = pk2(a[2], a[3]); w.z = pk2(b[0], b[1]); w.w = pk2(b[2], b[3]); *(u32x4*)p = w; }
DI void ld_bf8(const bf16_t* p, f32x4& a, f32x4& b) { const u32x4 w = *(const u32x4*)p; a[0] = bflo(w.x); a[1] = bfhi(w.x); a[2] = bflo(w.y); a[3] = bfhi(w.y); b[0] = bflo(w.z); b[1] = bfhi(w.z); b[2] = bflo(w.w); b[3] = bfhi(w.w); }
DI float sum4(f32x4 v) { return (v[0] + v[1]) + (v[2] + v[3]); }
DI float sumsq4(f32x4 v) { return (v[0] * v[0] + v[1] * v[1]) + (v[2] * v[2] + v[3] * v[3]); }
DI f32x4 gelu4(f32x4 v) { const f32x2 a = gelu_pk((f32x2){v[0], v[1]}), b = gelu_pk((f32x2){v[2], v[3]}); return (f32x4){a.x, a.y, b.x, b.y}; }
DI f32x4 sig4(f32x4 g) { return (f32x4){sigmoidf_(g[0]), sigmoidf_(g[1]), sigmoidf_(g[2]), sigmoidf_(g[3])}; }

struct EpiQKVG {
    bf16_t* out; const float* ss;
    DI void operator()(EPI_ARGS) const {
#pragma unroll
        for (int ai = 0; ai < 2; ++ai)
#pragma unroll
            for (int m = 0; m < 4; ++m) { const int row = ROW_OF(ai, m); const float rs = rs_from_ss_q(ss, row, fq);
#pragma unroll
                for (int bj = 0; bj < 2; ++bj) st_bf8(out + (size_t)row * 4096 + COL_OF(bj), acc[ai][bj][m][0] * rs, acc[ai][bj][m][1] * rs); }
    }
};
struct EpiSguIn {
    bf16_t* z; const float* ss; float* vst;
    DI void operator()(EPI_ARGS) const {
        const bool do_gelu = pn < 16, do_stats = (pn >= 8) && (pn < 16);
#pragma unroll
        for (int ai = 0; ai < 2; ++ai)
#pragma unroll
            for (int m = 0; m < 4; ++m) { const int row = ROW_OF(ai, m); const float rs = rs_from_ss_q(ss, row, fq); float s1 = 0.f, s2 = 0.f;
#pragma unroll
                for (int bj = 0; bj < 2; ++bj) { f32x4 v0 = acc[ai][bj][m][0] * rs, v1 = acc[ai][bj][m][1] * rs;
                    if (do_gelu) { v0 = gelu4(v0); v1 = gelu4(v1); }
                    s1 += sum4(v0) + sum4(v1); s2 += sumsq4(v0) + sumsq4(v1);
                    st_bf8(z + (size_t)row * 6144 + COL_OF(bj), v0, v1); }
                if (do_stats) { s1 = quad_sum(s1); s2 = quad_sum(s2);
                    if (fq == 0) *(f32x2*)(vst + ((size_t)row * 32 + (pn - 8) * 4 + wc) * 2) = (f32x2){s1, s2}; } }
    }
};
struct EpiRes {
    const bf16_t* xin; bf16_t* xb; int ldxb;
    DI void operator()(EPI_ARGS) const {
#pragma unroll
        for (int ai = 0; ai < 2; ++ai)
#pragma unroll
            for (int m = 0; m < 4; ++m) { const int row = ROW_OF(ai, m);
#pragma unroll
                for (int bj = 0; bj < 2; ++bj) { const int col = COL_OF(bj); f32x4 x0, x1; ld_bf8(xin + (size_t)row * 1024 + col, x0, x1);
                    st_bf8(xb + (size_t)row * ldxb + col, x0 + acc[ai][bj][m][0], x1 + acc[ai][bj][m][1]); } }
    }
};
struct EpiE {
    bf16_t* e; int lde;
    DI void operator()(EPI_ARGS) const {
#pragma unroll
        for (int ai = 0; ai < 2; ++ai)
#pragma unroll
            for (int m = 0; m < 4; ++m) { const int row = ROW_OF(ai, m);
#pragma unroll
                for (int bj = 0; bj < 2; ++bj) st_bf8(e + (size_t)row * lde + COL_OF(bj), acc[ai][bj][m][0], acc[ai][bj][m][1]); }
    }
};
struct EpiGate {
    const bf16_t* xm; int ldm; const bf16_t* e; int lde; bf16_t* xb; float* ss;
    DI void operator()(EPI_ARGS) const {
#pragma unroll
        for (int ai = 0; ai < 2; ++ai)
#pragma unroll
            for (int m = 0; m < 4; ++m) { const int row = ROW_OF(ai, m); float s2 = 0.f;
#pragma unroll
                for (int bj = 0; bj < 2; ++bj) { const int col = COL_OF(bj); f32x4 x0, x1, e0, e1;
                    ld_bf8(xm + (size_t)row * ldm + col, x0, x1); ld_bf8(e + (size_t)row * lde + col, e0, e1);
                    const f32x4 v0 = x0 + e0 * sig4(acc[ai][bj][m][0]), v1 = x1 + e1 * sig4(acc[ai][bj][m][1]);
                    s2 += sumsq4(v0) + sumsq4(v1);
                    st_bf8(xb + (size_t)row * 1024 + col, v0, v1); }
                s2 = quad_sum(s2);
                if (fq == 0) ss[(size_t)row * 16 + pn * 4 + wc] = s2; }
    }
};

template <int OFF> DI void tr8_issue_off(s16x4 (&lo)[4], s16x4 (&hi)[4], const unsigned (&a)[8]) {
    asm volatile("ds_read_b64_tr_b16 %0, %8 offset:%16\n\tds_read_b64_tr_b16 %1, %9 offset:%16\n\tds_read_b64_tr_b16 %2, %10 offset:%16\n\tds_read_b64_tr_b16 %3, %11 offset:%16\n\t"
                 "ds_read_b64_tr_b16 %4, %12 offset:%16\n\tds_read_b64_tr_b16 %5, %13 offset:%16\n\tds_read_b64_tr_b16 %6, %14 offset:%16\n\tds_read_b64_tr_b16 %7, %15 offset:%16"
                 : "=&v"(lo[0]), "=&v"(hi[0]), "=&v"(lo[1]), "=&v"(hi[1]), "=&v"(lo[2]), "=&v"(hi[2]), "=&v"(lo[3]), "=&v"(hi[3])
                 : "v"(a[0]), "v"(a[1]), "v"(a[2]), "v"(a[3]), "v"(a[4]), "v"(a[5]), "v"(a[6]), "v"(a[7]), "i"(OFF) : "memory");
}
template <int N> DI void tr8_wait(s16x4 (&lo)[4], s16x4 (&hi)[4]) {
    if (N == 0) asm volatile("s_waitcnt lgkmcnt(0)" : "+v"(lo[0]), "+v"(hi[0]), "+v"(lo[1]), "+v"(hi[1]), "+v"(lo[2]), "+v"(hi[2]), "+v"(lo[3]), "+v"(hi[3]) :: "memory");
    else asm volatile("s_waitcnt lgkmcnt(8)" : "+v"(lo[0]), "+v"(hi[0]), "+v"(lo[1]), "+v"(hi[1]), "+v"(lo[2]), "+v"(hi[2]), "+v"(lo[3]), "+v"(hi[3]) :: "memory");
}
DI bf16x8 cat8(s16x4 lo, s16x4 hi) { return (bf16x8){lo[0], lo[1], lo[2], lo[3], hi[0], hi[1], hi[2], hi[3]}; }

DI void attn_unit(const bf16_t* big, bf16_t* osp, int b, int h, int qb, float lam, float slope2, const float* subln_g, float oscale, char* lds_generic) {
    lds_uc* lds = (lds_uc*)lds_generic;
    const int tid = otid(), wid = __builtin_amdgcn_readfirstlane(tid >> 6), lane = tid & 63, w = wid & 3, j = wid >> 2, hf = lane >> 5, l32 = lane & 31;
    const int q0 = qb * 128;
    const size_t rowbase = (size_t)b * S_;
    const float NEG_INF = -__builtin_inff();
    bf16x8 qf[4];
    { const bf16_t* Qp = big + (rowbase + q0 + 32 * w + l32) * 4096 + h * 128 + j * 64;
#pragma unroll
      for (int ks = 0; ks < 4; ++ks) qf[ks] = *(const bf16x8*)(Qp + 16 * ks + 8 * hf); }
    f32x16 o[4];
#pragma unroll
    for (int mo = 0; mo < 4; ++mo)
#pragma unroll
        for (int r = 0; r < 16; ++r) o[mo][r] = 0.f;
    float l_run = 0.f;
    const int nkt = 2 * qb + 2;
    const bf16_t* srcK; const bf16_t* srcV0; const bf16_t* srcV1;
    { const int row = tid >> 3, cp = tid & 7; srcK = big + (rowbase + row) * 4096 + 1024 + h * 128 + ((cp ^ ((row >> 1) & 7)) << 3); }
    { const int s0 = tid, row = s0 >> 4, cp = s0 & 15; srcV0 = big + (rowbase + row) * 4096 + 2048 + h * 128 + ((cp ^ fxr(row)) << 3); }
    { const int s1 = tid + 512, row = s1 >> 4, cp = s1 & 15; srcV1 = big + (rowbase + row) * 4096 + 2048 + h * 128 + ((cp ^ fxr(row)) << 3); }
    const unsigned ldsw = (unsigned)wid * 1024u;
#define AT_DMA(kt_, bo_) do { const size_t _ko = (size_t)(kt_) * 64 * 4096; \
        __builtin_amdgcn_global_load_lds((const unsigned*)(srcK + _ko), (__attribute__((address_space(3))) unsigned*)(lds + (bo_) + ldsw), 16, 0, 0); \
        __builtin_amdgcn_global_load_lds((const unsigned*)(srcK + _ko + 64), (__attribute__((address_space(3))) unsigned*)(lds + (bo_) + 8192 + ldsw), 16, 0, 0); \
        __builtin_amdgcn_global_load_lds((const unsigned*)(srcV0 + _ko), (__attribute__((address_space(3))) unsigned*)(lds + (bo_) + 16384 + ldsw), 16, 0, 0); \
        __builtin_amdgcn_global_load_lds((const unsigned*)(srcV1 + _ko), (__attribute__((address_space(3))) unsigned*)(lds + (bo_) + 24576 + ldsw), 16, 0, 0); } while (0)
    const int g_blk = (lane >> 4) & 1, g_q = (lane & 15) >> 2, g_p = lane & 3;
    bf16x8 pf[4];
    unsigned voff[8];
#pragma unroll
    for (int mo = 0; mo < 4; ++mo)
#pragma unroll
        for (int t = 0; t < 2; ++t) { const int row = 8 * t + 4 * hf + g_q, ch = 4 * mo + 2 * g_blk + (g_p >> 1); voff[2 * mo + t] = (unsigned)(row * 256 + ((ch ^ fxr(row)) << 4) + 8 * (g_p & 1)); }
    f32x16 st[2];
    float ps_acc = 0.f;
    auto exp_chunk = [&](int kk) {
        const int mt = kk >> 1, s8 = (kk & 1) * 8; float e[8];
#pragma unroll
        for (int i = 0; i < 8; ++i) e[i] = __builtin_amdgcn_exp2f(st[mt][s8 + i]);
        ps_acc += ((e[0] + e[1]) + (e[2] + e[3])) + ((e[4] + e[5]) + (e[6] + e[7]));
        u32x4 pw; pw.x = pk2(e[0], e[1]); pw.y = pk2(e[2], e[3]); pw.z = pk2(e[4], e[5]); pw.w = pk2(e[6], e[7]);
        pf[kk] = __builtin_bit_cast(bf16x8, pw);
    };
    auto do_pv = [&](int bo) {
        const unsigned vbase = (unsigned)(uintptr_t)(lds + bo + 16384);
        s16x4 la[4], ha[4]; unsigned ad[8];
#pragma unroll
        for (int i = 0; i < 8; ++i) ad[i] = vbase + voff[i];
        tr8_issue_off<0>(la, ha, ad); exp_chunk(0); exp_chunk(1); tr8_wait<0>(la, ha);
#pragma unroll
        for (int mo = 0; mo < 4; ++mo) o[mo] = __builtin_amdgcn_mfma_f32_32x32x16_bf16(cat8(la[mo], ha[mo]), pf[0], o[mo], 0, 0, 0);
        asm volatile("s_nop 7\n\ts_nop 7" ::: "memory");
        tr8_issue_off<4096>(la, ha, ad); exp_chunk(2); tr8_wait<0>(la, ha);
#pragma unroll
        for (int mo = 0; mo < 4; ++mo) o[mo] = __builtin_amdgcn_mfma_f32_32x32x16_bf16(cat8(la[mo], ha[mo]), pf[1], o[mo], 0, 0, 0);
        asm volatile("s_nop 7\n\ts_nop 7" ::: "memory");
        tr8_issue_off<8192>(la, ha, ad); exp_chunk(3); tr8_wait<0>(la, ha);
#pragma unroll
        for (int mo = 0; mo < 4; ++mo) o[mo] = __builtin_amdgcn_mfma_f32_32x32x16_bf16(cat8(la[mo], ha[mo]), pf[2], o[mo], 0, 0, 0);
        asm volatile("s_nop 7\n\ts_nop 7" ::: "memory");
        tr8_issue_off<12288>(la, ha, ad); tr8_wait<0>(la, ha);
#pragma unroll
        for (int mo = 0; mo < 4; ++mo) o[mo] = __builtin_amdgcn_mfma_f32_32x32x16_bf16(cat8(la[mo], ha[mo]), pf[3], o[mo], 0, 0, 0);
    };
    auto do_pv_plain = [&](int bo) {
        const unsigned vbase = (unsigned)(uintptr_t)(lds + bo + 16384);
        s16x4 la[4], ha[4]; unsigned ad[8];
#pragma unroll
        for (int i = 0; i < 8; ++i) ad[i] = vbase + voff[i];
        tr8_issue_off<0>(la, ha, ad); tr8_wait<0>(la, ha);
        __builtin_amdgcn_s_setprio(1);
#pragma unroll
        for (int mo = 0; mo < 4; ++mo) o[mo] = __builtin_amdgcn_mfma_f32_32x32x16_bf16(cat8(la[mo], ha[mo]), pf[0], o[mo], 0, 0, 0);
        __builtin_amdgcn_s_setprio(0);
        asm volatile("s_nop 7\n\ts_nop 7" ::: "memory");
        tr8_issue_off<4096>(la, ha, ad); tr8_wait<0>(la, ha);
        __builtin_amdgcn_s_setprio(1);
#pragma unroll
        for (int mo = 0; mo < 4; ++mo) o[mo] = __builtin_amdgcn_mfma_f32_32x32x16_bf16(cat8(la[mo], ha[mo]), pf[1], o[mo], 0, 0, 0);
        __builtin_amdgcn_s_setprio(0);
        asm volatile("s_nop 7\n\ts_nop 7" ::: "memory");
        tr8_issue_off<8192>(la, ha, ad); tr8_wait<0>(la, ha);
        __builtin_amdgcn_s_setprio(1);
#pragma unroll
        for (int mo = 0; mo < 4; ++mo) o[mo] = __builtin_amdgcn_mfma_f32_32x32x16_bf16(cat8(la[mo], ha[mo]), pf[2], o[mo], 0, 0, 0);
        __builtin_amdgcn_s_setprio(0);
        asm volatile("s_nop 7\n\ts_nop 7" ::: "memory");
        tr8_issue_off<12288>(la, ha, ad); tr8_wait<0>(la, ha);
        __builtin_amdgcn_s_setprio(1);
#pragma unroll
        for (int mo = 0; mo < 4; ++mo) o[mo] = __builtin_amdgcn_mfma_f32_32x32x16_bf16(cat8(la[mo], ha[mo]), pf[3], o[mo], 0, 0, 0);
        __builtin_amdgcn_s_setprio(0);
    };
    __syncthreads();
    AT_DMA(nkt - 1, 0);
    asm volatile("s_waitcnt vmcnt(0)" ::: "memory");
    __syncthreads();
    int bo_cur = 0, bo_nxt = 32768, bo_prv = 65536;
    bool first = true, pending = false;
    float m_base = 0.f;
#pragma unroll 1
    for (int kt = nkt - 1; kt >= 0; --kt) {
        if (kt > 0) AT_DMA(kt - 1, bo_nxt);
        const bool skip = (64 * kt > q0 + 32 * w + 31);
        if (j == 1 && pending) do_pv_plain(bo_prv);
        if (!skip) {
            bf16x8 kf[8];
            { const lds_uc* kb = lds + bo_cur + j * 8192;
#pragma unroll
              for (int i = 0; i < 8; ++i) { const int mt = i >> 2, ks = i & 3, row = 32 * mt + l32, ch = 2 * ks + hf;
                  kf[i] = *(const __attribute__((address_space(3))) bf16x8*)(kb + row * 128 + ((ch ^ ((row >> 1) & 7)) << 4)); } }
            const float kbias = slope2 * (float)(64 * kt - q0 + 4 * hf) - m_base;
#pragma unroll
            for (int mt = 0; mt < 2; ++mt)
#pragma unroll
                for (int r = 0; r < 16; ++r) st[mt][r] = kbias + slope2 * (float)(32 * mt + (r & 3) + 8 * (r >> 2));
            __builtin_amdgcn_s_setprio(1);
#pragma unroll
            for (int ks = 0; ks < 4; ++ks)
#pragma unroll
                for (int mt = 0; mt < 2; ++mt) st[mt] = __builtin_amdgcn_mfma_f32_32x32x16_bf16(kf[mt * 4 + ks], qf[ks], st[mt], 0, 0, 0);
            __builtin_amdgcn_s_setprio(0);
            const bool diag = (64 * kt + 63 > q0 + 32 * w);
            if (diag) {
                const int qrel = q0 + 32 * w + l32 - 64 * kt - 4 * hf;
#pragma unroll
                for (int mt = 0; mt < 2; ++mt)
#pragma unroll
                    for (int r = 0; r < 16; ++r) { const int ko = 32 * mt + (r & 3) + 8 * (r >> 2); if (ko > qrel) st[mt][r] = NEG_INF; }
            }
            float tm = NEG_INF;
#pragma unroll
            for (int mt = 0; mt < 2; ++mt)
#pragma unroll
                for (int r = 0; r < 16; r += 2) tm = fmaxf(fmaxf(st[mt][r], st[mt][r + 1]), tm);
            tm = max_xor32(tm);
            const bool need = first || (tm > 8.f);
            if (__any(need)) {
                const float dm = need ? tm : 0.f;
                const float alpha = __builtin_amdgcn_exp2f(-dm);
                m_base += dm; l_run *= alpha;
#pragma unroll
                for (int mt = 0; mt < 2; ++mt)
#pragma unroll
                    for (int r = 0; r < 16; ++r) st[mt][r] -= dm;
#pragma unroll
                for (int mo = 0; mo < 4; ++mo)
#pragma unroll
                    for (int r = 0; r < 16; ++r) o[mo][r] *= alpha;
            }
            first = false;
            ps_acc = 0.f;
            if (j == 0) do_pv(bo_cur);
            else { exp_chunk(0); exp_chunk(1); exp_chunk(2); exp_chunk(3); pending = true; }
            l_run += ps_acc;
        }
        asm volatile("s_waitcnt vmcnt(0)" ::: "memory");
        __syncthreads();
        { const int t_ = bo_prv; bo_prv = bo_cur; bo_cur = bo_nxt; bo_nxt = t_; }
    }
    if (j == 1 && pending) do_pv_plain(bo_prv);
#undef AT_DMA
    const float l_tot = sum_xor32(l_run);
    float inv = 1.f / l_tot; if (j == 1) inv *= lam;
    __attribute__((address_space(3))) float* ex = (__attribute__((address_space(3))) float*)lds;
    __syncthreads();
    if (j == 1) {
#pragma unroll
        for (int mo = 0; mo < 4; ++mo)
#pragma unroll
            for (int r = 0; r < 16; ++r) ex[(w * 64 + mo * 16 + r) * 64 + lane] = o[mo][r] * inv;
    }
    __syncthreads();
    if (j == 0) {
        float sq = 0.f;
#pragma unroll
        for (int mo = 0; mo < 4; ++mo)
#pragma unroll
            for (int r = 0; r < 16; ++r) { const float v = o[mo][r] * inv - ex[(w * 64 + mo * 16 + r) * 64 + lane]; o[mo][r] = v; sq += v * v; }
        sq = sum_xor32(sq);
        const float rn = rsqrtf(sq * (1.f / 128.f) + 1e-5f) * oscale;
        const bf16_t* rowp = big + (rowbase + q0 + 32 * w + l32) * 4096 + h * 128;
        bf16_t* orow = osp + (rowbase + q0 + 32 * w + l32) * 1024 + h * 128;
#pragma unroll
        for (int mo = 0; mo < 4; ++mo)
#pragma unroll
            for (int rq = 0; rq < 4; ++rq) { const int dv = 32 * mo + 8 * rq + 4 * hf;
                const u32x2 gw = *(const u32x2*)(rowp + 3072 + dv); const f32x4 sg = *(const f32x4*)(subln_g + dv);
                f32x4 v;
                v[0] = o[mo][4 * rq + 0] * rn * sg[0] * siluf_(bflo(gw.x)); v[1] = o[mo][4 * rq + 1] * rn * sg[1] * siluf_(bfhi(gw.x));
                v[2] = o[mo][4 * rq + 2] * rn * sg[2] * siluf_(bflo(gw.y)); v[3] = o[mo][4 * rq + 3] * rn * sg[3] * siluf_(bfhi(gw.y));
                st_bf4(orow + dv, v); }
    }
}

DI void sgu_unit(bf16_t* z, int chunk, int g, const bf16_t* wsb, const float* bs, const float* lng, const float* lnb, const float* vst, char* lds_generic) {
    lds_uc* lds = (lds_uc*)lds_generic;
    const int tid = otid(), wid = __builtin_amdgcn_readfirstlane(tid >> 6), lane = tid & 63, tt = wid & 3, dh = wid >> 2, hf = lane >> 5, l32 = lane & 31;
    const int t0 = chunk * 128;
    __attribute__((address_space(3))) float* stt = (__attribute__((address_space(3))) float*)(lds + 72 * 1024);
    const int ch = tid & 31, r0 = tid >> 5;
    bf16_t* tile = z + (size_t)(t0 + r0) * 6144 + g * 256 + ch * 8;
    u32x4 raw[8];
#pragma unroll
    for (int i = 0; i < 8; ++i) raw[i] = *(const u32x4*)(tile + (size_t)(16 * i) * 6144 + 2048);
    const int nks = 2 * (tt + 1);
    bf16x8 wf[8];
#pragma unroll
    for (int ks = 0; ks < 8; ++ks) { if (ks < nks) wf[ks] = *(const bf16x8*)(wsb + ((size_t)g * 128 + 32 * tt + l32) * 128 + 16 * ks + 8 * hf); else wf[ks] = (bf16x8){0, 0, 0, 0, 0, 0, 0, 0}; }
    float gq[8], bq[8];
    { const f32x4 a = *(const f32x4*)(lng + g * 256 + ch * 8), b = *(const f32x4*)(lng + g * 256 + ch * 8 + 4), c = *(const f32x4*)(lnb + g * 256 + ch * 8), d = *(const f32x4*)(lnb + g * 256 + ch * 8 + 4);
#pragma unroll
      for (int i = 0; i < 4; ++i) { gq[i] = a[i]; gq[4 + i] = b[i]; bq[i] = c[i]; bq[4 + i] = d[i]; } }
    const float bsv = bs[g * 128 + 32 * tt + l32];
    __syncthreads();
    if (tid < 128) { const f32x4* pv = (const f32x4*)(vst + (size_t)(t0 + tid) * 64); float s1 = 0.f, s2 = 0.f;
#pragma unroll
        for (int i = 0; i < 16; ++i) { const f32x4 q4 = pv[i]; s1 += q4[0] + q4[2]; s2 += q4[1] + q4[3]; }
        const float mu = s1 * (1.f / 2048.f), var = s2 * (1.f / 2048.f) - mu * mu;
        stt[2 * tid] = mu; stt[2 * tid + 1] = rsqrtf(fmaxf(var, 0.f) + 1e-5f); }
    __syncthreads();
#pragma unroll
    for (int i = 0; i < 8; ++i) { const int row = r0 + 16 * i;
        const float mu = stt[2 * row], rstd = stt[2 * row + 1];
        float f[8]; f[0] = bflo(raw[i].x); f[1] = bfhi(raw[i].x); f[2] = bflo(raw[i].y); f[3] = bfhi(raw[i].y); f[4] = bflo(raw[i].z); f[5] = bfhi(raw[i].z); f[6] = bflo(raw[i].w); f[7] = bfhi(raw[i].w);
#pragma unroll
        for (int e = 0; e < 8; ++e) f[e] = (f[e] - mu) * rstd * gq[e] + bq[e];
        u32x4 w4; w4.x = pk2(f[0], f[1]); w4.y = pk2(f[2], f[3]); w4.z = pk2(f[4], f[5]); w4.w = pk2(f[6], f[7]);
        *(__attribute__((address_space(3))) u32x4*)(lds + row * 512 + ((ch ^ fxr(row)) << 4)) = w4; }
    __syncthreads();
    u32x4 uq[8], gt[8];
#pragma unroll
    for (int i = 0; i < 8; ++i) { uq[i] = *(const u32x4*)(tile + (size_t)(16 * i) * 6144); gt[i] = *(const u32x4*)(tile + (size_t)(16 * i) * 6144 + 4096); }
    f32x16 acc[4];
#pragma unroll
    for (int mo = 0; mo < 4; ++mo)
#pragma unroll
        for (int r = 0; r < 16; ++r) acc[mo][r] = 0.f;
    const int g_blk = (lane >> 4) & 1, g_q = (lane & 15) >> 2, g_p = lane & 3;
    auto ld_frag = [&](int ks, bf16x8 (&vf)[4]) {
#pragma unroll
        for (int mo = 0; mo < 4; ++mo) {
            const int row0 = 16 * ks + 8 * hf + g_q, row1 = row0 + 4, chx = 4 * (dh * 4 + mo) + 2 * g_blk + (g_p >> 1);
            const s16x4 lo = __builtin_amdgcn_ds_read_tr16_b64_v4i16((__attribute__((address_space(3))) s16x4*)(lds + row0 * 512 + ((chx ^ fxr(row0)) << 4) + 8 * (g_p & 1)));
            const s16x4 hi = __builtin_amdgcn_ds_read_tr16_b64_v4i16((__attribute__((address_space(3))) s16x4*)(lds + row1 * 512 + ((chx ^ fxr(row1)) << 4) + 8 * (g_p & 1)));
            vf[mo] = (bf16x8){lo[0], lo[1], lo[2], lo[3], hi[0], hi[1], hi[2], hi[3]};
        }
    };
    bf16x8 va[4], vb[4];
    ld_frag(0, va);
#pragma unroll
    for (int ks = 0; ks < 8; ks += 2) {
        if (ks < nks) {
            ld_frag(ks + 1, vb);
#pragma unroll
            for (int mo = 0; mo < 4; ++mo) acc[mo] = __builtin_amdgcn_mfma_f32_32x32x16_bf16(va[mo], wf[ks], acc[mo], 0, 0, 0);
            if (ks + 2 < nks) ld_frag(ks + 2, va);
#pragma unroll
            for (int mo = 0; mo < 4; ++mo) acc[mo] = __builtin_amdgcn_mfma_f32_32x32x16_bf16(vb[mo], wf[ks + 1], acc[mo], 0, 0, 0);
        }
    }
    __syncthreads();
#pragma unroll
    for (int mo = 0; mo < 4; ++mo)
#pragma unroll
        for (int rq = 0; rq < 4; ++rq) { const int d = (dh * 4 + mo) * 32 + 8 * rq + 4 * hf; u32x2 w2;
            w2.x = pk2(acc[mo][4 * rq + 0] + bsv, acc[mo][4 * rq + 1] + bsv); w2.y = pk2(acc[mo][4 * rq + 2] + bsv, acc[mo][4 * rq + 3] + bsv);
            *(__attribute__((address_space(3))) u32x2*)(lds + (32 * tt + l32) * 520 + d * 2) = w2; }
    __syncthreads();
#pragma unroll
    for (int i = 0; i < 8; ++i) { const int row = r0 + 16 * i;
        const u32x2 m0 = *(const __attribute__((address_space(3))) u32x2*)(lds + row * 520 + ch * 16), m1 = *(const __attribute__((address_space(3))) u32x2*)(lds + row * 520 + ch * 16 + 8);
        const u32x4 u4 = uq[i], g4 = gt[i]; u32x4 y;
        y.x = pk2(bflo(u4.x) * bflo(m0.x) * siluf_(bflo(g4.x)), bfhi(u4.x) * bfhi(m0.x) * siluf_(bfhi(g4.x)));
        y.y = pk2(bflo(u4.y) * bflo(m0.y) * siluf_(bflo(g4.y)), bfhi(u4.y) * bfhi(m0.y) * siluf_(bfhi(g4.y)));
        y.z = pk2(bflo(u4.z) * bflo(m1.x) * siluf_(bflo(g4.z)), bfhi(u4.z) * bfhi(m1.x) * siluf_(bfhi(g4.z)));
        y.w = pk2(bflo(u4.w) * bflo(m1.y) * siluf_(bflo(g4.w)), bfhi(u4.w) * bfhi(m1.y) * siluf_(bfhi(g4.w)));
        *(u32x4*)(tile + (size_t)(16 * i) * 6144) = y; }
}

DI float wave_sum(float v) {
#pragma unroll
    for (int o = 32; o > 0; o >>= 1) v += __shfl_xor(v, o);
    return v;
}

#define XB_TMO      128
#define XB_XCNT(j)  (256  + 64 * (j))
#define XB_XSUB(j)  (1280 + 64 * (j))
#define XB_XGEN(j)  (2304 + 64 * (j))
#define XB_TOP      3328
#define XB_TOPGEN   3392
#define XCD_BAR_WORDS 3456
#define XB_SPIN_CAP (1u << 18)
#define LAS __attribute__((address_space(3)))
DI unsigned xb_ld(unsigned* p)              { return __hip_atomic_load(p, __ATOMIC_RELAXED, __HIP_MEMORY_SCOPE_AGENT); }
DI unsigned xb_add(unsigned* p, unsigned v) { return __hip_atomic_fetch_add(p, v, __ATOMIC_RELAXED, __HIP_MEMORY_SCOPE_AGENT); }
DI unsigned xb_xcc_id() { return (unsigned)__builtin_amdgcn_s_getreg((3 << 11) | 20) & 0xFu; }
#define XB_SPIN(cond, bar) do { unsigned _sp = 0; while (cond) { __builtin_amdgcn_s_sleep(1); \
    if ((++_sp & 255u) == 0u) { if (xb_ld(&(bar)[XB_TMO])) break; if (_sp > XB_SPIN_CAP) { atomicAdd(&(bar)[XB_TMO], 1u); break; } } } } while (0)
struct XcdBarrier { unsigned* bar; unsigned x; volatile LAS unsigned* st; };
DI XcdBarrier xcd_barrier_post(unsigned* bar, volatile LAS unsigned* st) {
    XcdBarrier b; b.bar = bar; b.x = xb_xcc_id(); b.st = st;
    if (threadIdx.x == 0) (void)xb_add(&bar[XB_XCNT(b.x)], 1u);
    return b;
}
DI void xcd_barrier_complete(unsigned* bar, unsigned x, unsigned& nloc, unsigned& nx) {
    const unsigned G = gridDim.x * gridDim.y * gridDim.z;
    unsigned sum, cnt, mine, sp = 0u;
    for (;;) {
        sum = 0u; cnt = 0u; mine = 0u;
#pragma unroll
        for (unsigned j = 0; j < 16; ++j) { const unsigned c = xb_ld(&bar[XB_XCNT(j)]); sum += c; cnt += (c > 0u) ? 1u : 0u; mine = (j == x) ? c : mine; }
        if (sum == G) break;
        __builtin_amdgcn_s_sleep(1);
        if ((++sp & 255u) == 0u) { if (xb_ld(&bar[XB_TMO])) break; if (sp > XB_SPIN_CAP) { atomicAdd(&bar[XB_TMO], 1u); break; } }
    }
    nloc = mine > 0u ? mine : 1u; nx = cnt > 0u ? cnt : 1u;
}
template <class Work>
DI void xcd_barrier(const XcdBarrier& b, const Work& side_work) {
    asm volatile("s_waitcnt vmcnt(0)" ::: "memory");
    __syncthreads();
    if (threadIdx.x >= 64) side_work((int)threadIdx.x - 64);
    if (threadIdx.x == 0) {
        unsigned* bar = b.bar;
        __builtin_amdgcn_s_waitcnt(0);
        unsigned nloc = b.st[0], nx = b.st[1];
        if (nloc == 0u) { xcd_barrier_complete(bar, b.x, nloc, nx); b.st[0] = nloc; b.st[1] = nx; }
        const unsigned old = xb_add(&bar[XB_XSUB(b.x)], 1u);
        const unsigned gen = old / nloc;
        if (old + 1u == (gen + 1u) * nloc) {
            __builtin_amdgcn_fence(__ATOMIC_RELEASE, "agent");
            asm volatile("s_waitcnt vmcnt(0)" ::: "memory");
            const unsigned og = xb_add(&bar[XB_TOP], 1u);
            const unsigned tg = og / nx;
            if (og + 1u == (tg + 1u) * nx) xb_add(&bar[XB_TOPGEN], 1u);
            else XB_SPIN(xb_ld(&bar[XB_TOPGEN]) == tg, bar);
            __builtin_amdgcn_fence(__ATOMIC_ACQUIRE, "agent");
            xb_add(&bar[XB_XGEN(b.x)], 1u);
            asm volatile("s_waitcnt vmcnt(0)" ::: "memory");
        } else {
            XB_SPIN(xb_ld(&bar[XB_XGEN(b.x)]) == gen, bar);
            __builtin_amdgcn_fence(__ATOMIC_ACQUIRE, "agent");
            asm volatile("s_waitcnt vmcnt(0)" ::: "memory");
        }
    }
    __syncthreads();
}

typedef const __attribute__((address_space(4))) Params* kparams_t;
#define KP kparams_t pp = (kparams_t)__builtin_amdgcn_kernarg_segment_ptr(); asm volatile("" : "+s"(pp)); char* ws = pp->ws; (void)ws;
#define W_XB ((bf16_t*)(ws + OFF_XB))
#define W_BIG ((bf16_t*)(ws + OFF_BIG))
#define W_OSP ((bf16_t*)(ws + OFF_BIG + 256 * MiB))
#define W_WIN ((bf16_t*)(ws + OFF_WIN))
#define W_WOA ((bf16_t*)(ws + OFF_WOA))
#define W_WOS ((bf16_t*)(ws + OFF_WOS))
#define W_WP ((bf16_t*)(ws + OFF_WP))
#define W_WG ((bf16_t*)(ws + OFF_WG))
#define W_PB ((bf16_t*)(ws + OFF_PB))
#define W_SS ((float*)(ws + OFF_SS))
#define W_VST ((float*)(ws + OFF_VST))
#define W_WSB ((bf16_t*)(ws + OFF_WSB))

__global__ __launch_bounds__(512) void mega_fwd(Params P_unused) {
    extern __shared__ __attribute__((aligned(16))) char lds[];
    cg::grid_group grid = cg::this_grid();
    const int G = gridDim.x;
    __shared__ uint4 xb_words;
    if (threadIdx.x == 0) xb_words = make_uint4(0u, 0u, 0u, 0u);
    {
        PH_BEGIN(0)
        KP
        if (blockIdx.x == 0) { unsigned* bar = (unsigned*)(ws + OFF_BAR); for (int i = threadIdx.x; i < XCD_BAR_WORDS; i += 512) bar[i] = 0u; }
        {
            const int tx = otid();
            constexpr int I_WO = 1024 * 32, I_SO = 1024 * 64, I_PP = 1024 * 8, I_PG = 1024 * 32, I_WI = 4096 * 32;
            constexpr int total = 2 * I_WO + 2 * I_SO + 4 * I_PP + 4 * I_PG + I_WI;
            for (int it = blockIdx.x * 512 + tx; it < total; it += G * 512) {
                int r = it;
                if (r < 2 * I_WO) { const int j = r / I_WO; conv_item(pp->attn_w_out + (size_t)j * 1024 * 1024, 1024, 1024, W_WOA + (size_t)j * 1024 * 1024, nullptr, 0, 1.f, r % I_WO); continue; }
                r -= 2 * I_WO;
                if (r < 2 * I_SO) { const int j = r / I_SO; conv_item(pp->sgu_w_out + (size_t)j * 2048 * 1024, 2048, 1024, W_WOS + (size_t)j * 1024 * 2048, nullptr, 0, 1.f, r % I_SO); continue; }
                r -= 2 * I_SO;
                if (r < 4 * I_PP) { const int j = r / I_PP; conv_item(pp->ple_proj + (size_t)j * 256 * 1024, 256, 1024, W_WP + (size_t)j * 1024 * 256, nullptr, 0, 1.f, r % I_PP); continue; }
                r -= 4 * I_PP;
                if (r < 4 * I_PG) { const int j = r / I_PG; conv_item(pp->ple_gate + (size_t)j * 1024 * 1024, 1024, 1024, W_WG + (size_t)j * 1024 * 1024, nullptr, 0, 1.f, r % I_PG); continue; }
                r -= 4 * I_PG;
                conv_item(pp->attn_w_in, 1024, 4096, W_WIN, pp->attn_norm, 1024, 0.125f * LOG2E, r);
            }
        }
        { const int tid = otid(); const float* wsrc = pp->w_s; bf16_t* wdst = W_WSB;
          for (size_t e = (size_t)blockIdx.x * 512 + tid; e < (size_t)2 * 8 * 128 * 128; e += (size_t)G * 512) {
              const int s = (int)(e & 127), t = (int)((e >> 7) & 127);
              wdst[e] = (s <= t) ? f2bf(wsrc[e]) : (bf16_t)0; } }
        { const int tid = otid(), wid = tid >> 6, lane = tid & 63; const float* x = pp->x; bf16_t* XB = W_XB; float* SS = W_SS;
          for (int row = blockIdx.x * 8 + wid; row < T_; row += G * 8) {
              const float* xr = x + (size_t)row * 1024; float sq = 0.f;
#pragma unroll
              for (int i = 0; i < 4; ++i) { const f32x4 v = *(const f32x4*)(xr + i * 256 + lane * 4); sq += (v[0] * v[0] + v[1] * v[1]) + (v[2] * v[2] + v[3] * v[3]);
                  st_bf4(XB + (size_t)row * 1024 + i * 256 + lane * 4, v); }
              sq = wave_sum(sq);
              if (lane < 16) SS[(size_t)row * 16 + lane] = (lane == 0) ? sq : 0.f; } }
        conv_flat(pp->p, W_PB, (size_t)T_ * 256);
        PH_END(0)
    }
    grid.sync();
    { KP (void)xcd_barrier_post((unsigned*)(ws + OFF_BAR), (volatile LAS unsigned*)&xb_words); }
#define XBAR_W(WORK) do { KP XcdBarrier xb_; xb_.bar = (unsigned*)(ws + OFF_BAR); xb_.x = xb_xcc_id(); xb_.st = (volatile LAS unsigned*)&xb_words; xcd_barrier(xb_, WORK); } while (0)
#define XBAR XBAR_W([](int) {})

#pragma unroll 1
    for (int layer = 0; layer < 4; ++layer) {
        const int jl = layer >> 1;
        if ((layer & 1) == 0) {
            { PH_BEGIN(1)
            { KP EpiQKVG epi{W_BIG, W_SS}; gemm_phase(lds, W_XB, 1024, W_WIN, 1024, 1024, T_, 4096, epi, STAGGER_TICKS); }
            PH_END(1) }
            XBAR_W([&](int lt) { if (layer > 0) conv_flat_part(pp->p + (size_t)layer * T_ * 256, W_PB, (size_t)T_ * 256, lt, 448, 1, 2); });
            for (int rep = 0; rep < PROBE_ATTN_REPS; ++rep) {
                PH_BEGIN(2)
                KP
                float lam; const int lane = otid() & 63;
                const float li = (layer == 0 ? pp->lam_init0 : pp->lam_init2);
                { const float a = pp->lq1[jl * 64 + lane] * pp->lk1[jl * 64 + lane], b2 = pp->lq2[jl * 64 + lane] * pp->lk2[jl * 64 + lane];
                  lam = __expf(wave_sum(a)) - __expf(wave_sum(b2)) + li; }
                const float oscale = 1.f - li;
                const float* sg = pp->subln + jl * 128;
                bf16_t* BIG = W_BIG; bf16_t* OSP = W_OSP;
#pragma unroll 1
                for (int pr = blockIdx.x; pr < 1024; pr += G) {
                    const int c = pr & 255, i = pr >> 8, xcd = c & 7, slot = c >> 3;
                    const int bh = i * 16 + xcd * 2 + (slot >> 4), pq = slot & 15, b = bh >> 3, h = bh & 7;
                    const float slope2 = exp2f(-(float)(h + 1)) * LOG2E;
                    attn_unit(BIG, OSP, b, h, 31 - pq, lam, slope2, sg, oscale, lds);
                    attn_unit(BIG, OSP, b, h, pq, lam, slope2, sg, oscale, lds);
                }
                PH_END(2)
            }
            XBAR_W([&](int lt) { conv_T_part(pp->sgu_w_in + (size_t)jl * 1024 * 6144, 1024, 6144, W_WIN, pp->sgu_norm + jl * 1024, 0, 1.f, lt, 448, 0, 2); });
            { PH_BEGIN(3)
            { KP EpiRes epi{W_XB, W_BIG + 2048, 4096}; gemm_phase(lds, W_OSP, 1024, W_WOA + (size_t)jl * 1024 * 1024, 1024, 1024, T_, 1024, epi); }
            { KP EpiE epi{W_BIG + 1024, 4096}; gemm_phase(lds, W_PB, 256, W_WP + (size_t)layer * 1024 * 256, 256, 256, T_, 1024, epi); }
            PH_END(3) }
            XBAR_W([&](int lt) { conv_T_part(pp->sgu_w_in + (size_t)jl * 1024 * 6144, 1024, 6144, W_WIN, pp->sgu_norm + jl * 1024, 0, 1.f, lt, 448, 1, 2); });
            { PH_BEGIN(4)
            { KP EpiGate epi{W_BIG + 2048, 4096, W_BIG + 1024, 4096, W_XB, W_SS}; gemm_phase(lds, W_BIG + 2048, 4096, W_WG + (size_t)layer * 1024 * 1024, 1024, 1024, T_, 1024, epi); }
            PH_END(4) }
            XBAR_W([&](int lt) { conv_flat_part(pp->p + (size_t)(layer + 1) * T_ * 256, W_PB, (size_t)T_ * 256, lt, 448, 0, 2); });
        } else {
            { PH_BEGIN(5)
            { KP EpiSguIn epi{W_BIG, W_SS, W_VST}; gemm_phase(lds, W_XB, 1024, W_WIN, 1024, 1024, T_, 6144, epi, STAGGER_TICKS); }
            PH_END(5) }
            XBAR_W([&](int lt) { if (layer > 0) conv_flat_part(pp->p + (size_t)layer * T_ * 256, W_PB, (size_t)T_ * 256, lt, 448, 1, 2); });
            { PH_BEGIN(6) KP
              const bf16_t* wsb = W_WSB + (size_t)jl * 8 * 128 * 128; const float* bs = pp->b_s + jl * 8 * 128; const float* lg = pp->ln_g + jl * 2048; const float* lb = pp->ln_b + jl * 2048;
              bf16_t* BIG = W_BIG; const float* VST = W_VST;
#pragma unroll 1
              for (int u = blockIdx.x; u < 2048; u += G) sgu_unit(BIG, u >> 3, u & 7, wsb, bs, lg, lb, VST, lds);
              PH_END(6) }
            XBAR_W([&](int lt) { if (layer + 1 < 4) conv_T_part(pp->attn_w_in + (size_t)(jl + 1) * 1024 * 4096, 1024, 4096, W_WIN, pp->attn_norm + (jl + 1) * 1024, 1024, 0.125f * LOG2E, lt, 448, 0, 2); });
            { PH_BEGIN(7)
            { KP EpiRes epi{W_XB, W_BIG + 4096, 6144}; gemm_phase(lds, W_BIG, 6144, W_WOS + (size_t)jl * 1024 * 2048, 2048, 2048, T_, 1024, epi); }
            { KP EpiE epi{W_BIG + 2048, 6144}; gemm_phase(lds, W_PB, 256, W_WP + (size_t)layer * 1024 * 256, 256, 256, T_, 1024, epi); }
            PH_END(7) }
            XBAR_W([&](int lt) { if (layer + 1 < 4) conv_T_part(pp->attn_w_in + (size_t)(jl + 1) * 1024 * 4096, 1024, 4096, W_WIN, pp->attn_norm + (jl + 1) * 1024, 1024, 0.125f * LOG2E, lt, 448, 1, 2); });
            { PH_BEGIN(8)
            { KP EpiGate epi{W_BIG + 4096, 6144, W_BIG + 2048, 6144, W_XB, W_SS}; gemm_phase(lds, W_BIG + 4096, 6144, W_WG + (size_t)layer * 1024 * 1024, 1024, 1024, T_, 1024, epi); }
            PH_END(8) }
            XBAR_W([&](int lt) { if (layer + 1 < 4) conv_flat_part(pp->p + (size_t)(layer + 1) * T_ * 256, W_PB, (size_t)T_ * 256, lt, 448, 0, 2); });
        }
    }
    {
        PH_BEGIN(9)
        KP
        const int tid = otid(), wid = tid >> 6, lane = tid & 63; float* OUT = pp->out; const bf16_t* XB = W_XB; const float* SS = W_SS; const float* fg = pp->final_norm;
        for (int row = blockIdx.x * 8 + wid; row < T_; row += G * 8) {
            const float rs = rs_from_ss(SS, row);
#pragma unroll
            for (int i = 0; i < 2; ++i) { const int c = i * 512 + lane * 8; const u32x4 xw = *(const u32x4*)(XB + (size_t)row * 1024 + c);
                const f32x4 g0 = *(const f32x4*)(fg + c), g1 = *(const f32x4*)(fg + c + 4);
                f32x4 o0, o1; o0[0] = bflo(xw.x) * rs * g0[0]; o0[1] = bfhi(xw.x) * rs * g0[1]; o0[2] = bflo(xw.y) * rs * g0[2]; o0[3] = bfhi(xw.y) * rs * g0[3];
                o1[0] = bflo(xw.z) * rs * g1[0]; o1[1] = bfhi(xw.z) * rs * g1[1]; o1[2] = bflo(xw.w) * rs * g1[2]; o1[3] = bfhi(xw.w) * rs * g1[3];
                *(f32x4*)(OUT + (size_t)row * 1024 + c) = o0; *(f32x4*)(OUT + (size_t)row * 1024 + c + 4) = o1; }
        }
        PH_END(9)
    }
}

extern "C" void kernel_launch(void* const* d_in, const int* in_sizes, int n_in, void* d_out, int out_size, void* d_ws, size_t ws_size, hipStream_t stream) {
    static int grid_blocks = 0;
    if (!grid_blocks) {
        int dev = 0, cus = 0, per_cu = 0;
        hipGetDevice(&dev);
        hipDeviceGetAttribute(&cus, hipDeviceAttributeMultiprocessorCount, dev);
        hipFuncSetAttribute((const void*)mega_fwd, hipFuncAttributeMaxDynamicSharedMemorySize, LDS_BYTES);
        hipOccupancyMaxActiveBlocksPerMultiprocessor(&per_cu, mega_fwd, 512, LDS_BYTES);
        if (per_cu < 1) per_cu = 1;
        grid_blocks = cus * 1;
    }
    Params P{};
    const float** pp = (const float**)&P;
    for (int i = 0; i < 20; ++i) pp[i] = (const float*)d_in[i];
    P.out = (float*)d_out; P.ws = (char*)d_ws;
    P.lam_init0 = 0.2f; P.lam_init2 = (float)(0.8 - 0.6 * 0.54881163609402643);
    void* args[] = {&P};
    hipError_t e = hipLaunchCooperativeKernel((void*)mega_fwd, dim3(grid_blocks), dim3(512), args, LDS_BYTES, stream);
    if (e != hipSuccess) fprintf(stderr, "cooperative launch failed: %s (grid %d)\n", hipGetErrorString(e), grid_blocks);
}
```
